# Optimizing an MI355X kernel written in HIP

```python
import math
import jax, jax.numpy as jnp
from jax import lax
import numpy as np

D_MODEL = 1024
BATCH = 32
SEQ = 2048
DEPTH = 1

CHUNK = 64
SSM_GROUP = 16
D_SSM = D_MODEL // 4
SSM_GROUPS = D_SSM // SSM_GROUP
SSM_STATE = 64
DT_MIN = 0.001
DT_MAX = 0.1
D_POOL = D_MODEL // 2
POOL_WINDOWS = (2, 4, 8, 16)
POOL_GROUPS = len(POOL_WINDOWS)
POOL_GC = D_POOL // POOL_GROUPS
POOL_MAX = max(POOL_WINDOWS)
D_IN = D_SSM + D_POOL + 2 * D_MODEL
N_EXPERT_GROUPS = 4
EXPERTS_PER_GROUP = 8
N_EXPERTS = N_EXPERT_GROUPS * EXPERTS_PER_GROUP
TOP_K_FINE = 2
D_EXPERT = D_MODEL // 2
N_MOD = 6
EPS = 1e-6

kernel_name = "hybrid_s5_pool_hiermoe_block"


def rms_norm(x, g):
    xf = x.astype(jnp.float32)
    y = xf * lax.rsqrt(jnp.mean(xf * xf, axis=-1, keepdims=True) + EPS)
    return (y * g.astype(jnp.float32)).astype(x.dtype)


def modulate(h, g, shift, scale):
    return rms_norm(h, g) * (1.0 + scale[:, None, :]) + shift[:, None, :]


def s5_mixer(u, lam_re, lam_im, log_dt, b_re, b_im, c_re, c_im, d_skip, w_glu, b_glu):
    bsz, seq, _ = u.shape
    uf = u.astype(jnp.float32).reshape(bsz, seq, SSM_GROUPS, SSM_GROUP)
    lr = lam_re.astype(jnp.float32)
    li = lam_im.astype(jnp.float32)
    dt = jnp.exp(log_dt.astype(jnp.float32))[:, None]
    mag = jnp.exp(lr * dt)
    lb_re = mag * jnp.cos(li * dt)
    lb_im = mag * jnp.sin(li * dt)
    den = lr * lr + li * li
    nr = lb_re - 1.0
    f_re = (nr * lr + lb_im * li) / den
    f_im = (lb_im * lr - nr * li) / den
    br = b_re.astype(jnp.float32)
    bi = b_im.astype(jnp.float32)
    bb_re = f_re[..., None] * br - f_im[..., None] * bi
    bb_im = f_re[..., None] * bi + f_im[..., None] * br
    bu_re = jnp.einsum('bsgh,gph->bsgp', uf, bb_re)
    bu_im = jnp.einsum('bsgh,gph->bsgp', uf, bb_im)
    a_re = jnp.broadcast_to(lb_re, (1, seq, SSM_GROUPS, SSM_STATE))
    a_im = jnp.broadcast_to(lb_im, (1, seq, SSM_GROUPS, SSM_STATE))

    def combine(left, right):
        ar_l, ai_l, xr_l, xi_l = left
        ar_r, ai_r, xr_r, xi_r = right
        ar = ar_r * ar_l - ai_r * ai_l
        ai = ar_r * ai_l + ai_r * ar_l
        xr = ar_r * xr_l - ai_r * xi_l + xr_r
        xi = ar_r * xi_l + ai_r * xr_l + xi_r
        return (ar, ai, xr, xi)

    _, _, st_re, st_im = lax.associative_scan(combine, (a_re, a_im, bu_re, bu_im), axis=1)
    y = (jnp.einsum('bsgp,ghp->bsgh', st_re, c_re.astype(jnp.float32))
         - jnp.einsum('bsgp,ghp->bsgh', st_im, c_im.astype(jnp.float32))
         + d_skip.astype(jnp.float32).reshape(SSM_GROUPS, SSM_GROUP) * uf)
    y = jax.nn.gelu(y.reshape(bsz, seq, D_SSM))
    z = y * jax.nn.sigmoid(y @ w_glu.astype(jnp.float32) + b_glu.astype(jnp.float32))
    return z.astype(u.dtype)


def pool_mixer(u, w_pool, pool_scale):
    bsz, seq, _ = u.shape
    uf = u.astype(jnp.float32)
    cs = jnp.pad(jnp.cumsum(uf, axis=1), ((0, 0), (POOL_MAX, 0), (0, 0)))
    pos = jnp.arange(seq, dtype=jnp.float32)
    outs = []
    for gi, w in enumerate(POOL_WINDOWS):
        lo, hi = gi * POOL_GC, (gi + 1) * POOL_GC
        win = cs[:, POOL_MAX:POOL_MAX + seq, lo:hi] - cs[:, POOL_MAX - w:POOL_MAX - w + seq, lo:hi]
        cnt = jnp.minimum(pos + 1.0, float(w))[None, :, None]
        outs.append(win / cnt - uf[:, :, lo:hi])
    m = jnp.stack(outs, axis=2)
    y = jnp.einsum('bsgc,gcd->bsgd', m, w_pool.astype(jnp.float32)).reshape(bsz, seq, D_POOL)
    return (y * pool_scale.astype(jnp.float32)).astype(u.dtype)


def hier_moe(u, w_coarse, b_coarse, w_fine, b_fine, w_gate, w_up, w_down):
    bsz, seq, d = u.shape
    n_tok = bsz * seq
    xf = u.reshape(n_tok, d)
    x32 = xf.astype(jnp.float32)
    coarse = x32 @ w_coarse.astype(jnp.float32) + b_coarse.astype(jnp.float32)
    p_coarse = jax.nn.softmax(coarse, axis=-1)
    _, grp = lax.top_k(coarse, 1)
    p_grp = jnp.take_along_axis(p_coarse, grp, axis=-1)
    fine = (x32 @ w_fine.astype(jnp.float32) + b_fine.astype(jnp.float32)).reshape(
        n_tok, N_EXPERT_GROUPS, EXPERTS_PER_GROUP)
    fine_sel = jnp.take_along_axis(fine, grp[:, :, None], axis=1)[:, 0, :]
    p_fine = jax.nn.softmax(fine_sel, axis=-1)
    top_p, top_i = lax.top_k(p_fine, TOP_K_FINE)
    weights = p_grp * top_p / jnp.sum(top_p, axis=-1, keepdims=True)
    expert = grp * EXPERTS_PER_GROUP + top_i

    e_flat = expert.reshape(-1)
    w_flat = weights.reshape(-1)
    tok_flat = jnp.repeat(jnp.arange(n_tok, dtype=jnp.int32), TOP_K_FINE)
    order = jnp.argsort(e_flat)
    tok_sorted = tok_flat[order]
    w_sorted = w_flat[order]
    group_sizes = jnp.bincount(e_flat, length=N_EXPERTS).astype(jnp.int32)
    xs = xf[tok_sorted]
    h1 = lax.ragged_dot(xs, w_gate.astype(xs.dtype), group_sizes)
    h2 = lax.ragged_dot(xs, w_up.astype(xs.dtype), group_sizes)
    act = jax.nn.silu(h1) * h2
    ys = lax.ragged_dot(act, w_down.astype(act.dtype), group_sizes)
    ys = ys * w_sorted[:, None].astype(ys.dtype)
    out = jax.ops.segment_sum(ys, tok_sorted, num_segments=n_tok)
    return out.reshape(bsz, seq, d).astype(u.dtype)


def setup_inputs(seed: int = 0) -> dict:
    key = jax.random.key(seed)
    ks = jax.random.split(key, 32)
    f32 = jnp.float32
    L, D = DEPTH, D_MODEL
    nrm = lambda k, shape, s: jax.random.normal(k, shape, f32) * s
    n_idx = jnp.arange(SSM_STATE, dtype=f32)
    lam_re = -0.5 + 0.01 * jax.random.normal(ks[6], (L, SSM_GROUPS, SSM_STATE), f32)
    lam_im = math.pi * n_idx[None, None, :] + 0.01 * jax.random.normal(ks[7], (L, SSM_GROUPS, SSM_STATE), f32)
    log_dt = jax.random.uniform(ks[8], (L, SSM_GROUPS), f32, math.log(DT_MIN), math.log(DT_MAX))
    return {
        "x": nrm(ks[0], (BATCH, SEQ, D), 1.0),
        "c": nrm(ks[1], (BATCH, D), 1.0),
        "w_mod": nrm(ks[2], (L, D, N_MOD * D), D ** -0.5),
        "b_mod": nrm(ks[3], (L, N_MOD * D), 0.02),
        "norm1_g": 1.0 + nrm(ks[4], (L, D), 0.05),
        "w_in": nrm(ks[5], (L, D, D_IN), D ** -0.5),
        "b_in": nrm(ks[9], (L, D_IN), 0.02),
        "ssm_lam_re": lam_re,
        "ssm_lam_im": lam_im,
        "ssm_log_dt": log_dt,
        "ssm_b_re": nrm(ks[10], (L, SSM_GROUPS, SSM_STATE, SSM_GROUP), (2 * SSM_GROUP) ** -0.5),
        "ssm_b_im": nrm(ks[11], (L, SSM_GROUPS, SSM_STATE, SSM_GROUP), (2 * SSM_GROUP) ** -0.5),
        "ssm_c_re": nrm(ks[12], (L, SSM_GROUPS, SSM_GROUP, SSM_STATE), SSM_STATE ** -0.5),
        "ssm_c_im": nrm(ks[13], (L, SSM_GROUPS, SSM_GROUP, SSM_STATE), SSM_STATE ** -0.5),
        "ssm_d": nrm(ks[14], (L, D_SSM), 1.0),
        "ssm_w_glu": nrm(ks[15], (L, D_SSM, D_SSM), D_SSM ** -0.5),
        "ssm_b_glu": nrm(ks[16], (L, D_SSM), 0.02),
        "pool_w": nrm(ks[17], (L, POOL_GROUPS, POOL_GC, POOL_GC), POOL_GC ** -0.5),
        "pool_scale": 1.0 + nrm(ks[18], (L, D_POOL), 0.1),
        "w_proj_ssm": nrm(ks[19], (L, D_SSM, D), D_SSM ** -0.5),
        "w_proj_pool": nrm(ks[20], (L, D_POOL, D), D_POOL ** -0.5),
        "w_out": nrm(ks[21], (L, D, D), D ** -0.5),
        "norm2_g": 1.0 + nrm(ks[22], (L, D), 0.05),
        "router_coarse_w": nrm(ks[23], (L, D, N_EXPERT_GROUPS), D ** -0.5),
        "router_coarse_b": nrm(ks[24], (L, N_EXPERT_GROUPS), 0.01),
        "router_fine_w": nrm(ks[25], (L, D, N_EXPERTS), D ** -0.5),
        "router_fine_b": nrm(ks[26], (L, N_EXPERTS), 0.01),
        "moe_w_gate": nrm(ks[27], (L, N_EXPERTS, D, D_EXPERT), D ** -0.5),
        "moe_w_up": nrm(ks[28], (L, N_EXPERTS, D, D_EXPERT), D ** -0.5),
        "moe_w_down": nrm(ks[29], (L, N_EXPERTS, D_EXPERT, D), D_EXPERT ** -0.5),
        "norm_f_g": 1.0 + nrm(ks[30], (D,), 0.05),
    }


def reference(x, c, w_mod, b_mod, norm1_g, w_in, b_in, ssm_lam_re, ssm_lam_im, ssm_log_dt,
              ssm_b_re, ssm_b_im, ssm_c_re, ssm_c_im, ssm_d, ssm_w_glu, ssm_b_glu,
              pool_w, pool_scale, w_proj_ssm, w_proj_pool, w_out, norm2_g,
              router_coarse_w, router_coarse_b, router_fine_w, router_fine_b,
              moe_w_gate, moe_w_up, moe_w_down, norm_f_g):
    h = x
    c_act = jax.nn.silu(c)
    for l in range(DEPTH):
        mod = c_act @ w_mod[l] + b_mod[l]
        shift1, scale1, gate1, shift2, scale2, gate2 = jnp.split(mod, N_MOD, axis=-1)

        u = modulate(h, norm1_g[l], shift1, scale1)
        proj = u @ w_in[l] + b_in[l]
        u_ssm = proj[..., :D_SSM]
        u_pool = proj[..., D_SSM:D_SSM + D_POOL]
        g_ssm = jax.nn.sigmoid(proj[..., D_SSM + D_POOL:D_SSM + D_POOL + D_MODEL])
        g_pool = jax.nn.sigmoid(proj[..., D_SSM + D_POOL + D_MODEL:])
        a = s5_mixer(u_ssm, ssm_lam_re[l], ssm_lam_im[l], ssm_log_dt[l], ssm_b_re[l], ssm_b_im[l],
                     ssm_c_re[l], ssm_c_im[l], ssm_d[l], ssm_w_glu[l], ssm_b_glu[l])
        b = pool_mixer(u_pool, pool_w[l], pool_scale[l])
        merged = g_ssm * (a @ w_proj_ssm[l]) + g_pool * (b @ w_proj_pool[l])
        h = h + gate1[:, None, :] * (merged @ w_out[l])

        u2 = modulate(h, norm2_g[l], shift2, scale2)
        y = hier_moe(u2, router_coarse_w[l], router_coarse_b[l], router_fine_w[l], router_fine_b[l],
                     moe_w_gate[l], moe_w_up[l], moe_w_down[l])
        h = h + gate2[:, None, :] * y
    return rms_norm(h, norm_f_g)
```

```cpp
#include <hip/hip_runtime.h>
#include <cstdio>

#ifndef MK_N_LAUNCHES
#define MK_N_LAUNCHES 7
#endif

#define GAS __attribute__((address_space(1)))
#define LAS __attribute__((address_space(3)))
typedef unsigned short bf16;
typedef short bf16x8 __attribute__((ext_vector_type(8)));
typedef float f32x4 __attribute__((ext_vector_type(4)));
typedef float f32x2 __attribute__((ext_vector_type(2)));
typedef unsigned u32x4 __attribute__((ext_vector_type(4)));
typedef unsigned u32x2 __attribute__((ext_vector_type(2)));
#define LDS_WAIT() asm volatile("s_waitcnt lgkmcnt(0)" ::: "memory")
#define VM_WAIT() asm volatile("s_waitcnt vmcnt(0)" ::: "memory")
#define WG_SYNC() do { asm volatile("s_waitcnt vmcnt(0) lgkmcnt(0)" ::: "memory"); __syncthreads(); } while (0)

constexpr int D = 1024, NB = 32, SEQ = 2048, T = NB * SEQ, DIN = 2816, DSSM = 256, DPOOL = 512;
constexpr int NG = 16, GH = 16, NP = 64, CH = 64, NCOL = T / CH  , KX = 128 + CH * GH  ;
constexpr int NE = 32, DE = 512, CAP = 65536, NMOD = 6 * D;
constexpr int YS_ROWS = 2 * T + NE * 256;
constexpr float EPS = 1e-6f;
constexpr int NWAVES = 8, NTHR = 512;

constexpr size_t MiB = 1u << 20;
constexpr size_t WS_CTL = 0, CTL_ZERO_BYTES = 1 * MiB;
constexpr size_t WS_MOD = 1 * MiB, WS_LPOW = 2 * MiB, WS_BBAR = 3 * MiB, WS_KTAB = 4 * MiB, WS_TOKSLOT = 5 * MiB, WS_SORTED = 6 * MiB, WS_SLOTW = 14 * MiB, WS_LOGITS = 22 * MiB;
constexpr size_t WS_WIN = 38 * MiB, WS_WGLU = 44 * MiB, WS_PSSM = 45 * MiB, WS_WEFF = 46 * MiB, WS_WOUT = 47 * MiB, WS_WR = 49 * MiB, WS_W1 = 50 * MiB, WS_WD = 114 * MiB;
constexpr size_t WS_TG = 146 * MiB, WS_ET = 182 * MiB, WS_SSUM = 190 * MiB, WS_H1 = 222 * MiB, WS_U2 = 350 * MiB;
constexpr size_t WS_U = 478 * MiB, WS_UX = 606 * MiB, WS_UPOOL = 642 * MiB, WS_Y = 706 * MiB, WS_Z = 738 * MiB, WS_M = 770 * MiB, WS_END = 834 * MiB;
constexpr size_t WS_YS = WS_U;
static_assert(WS_YS + (size_t)YS_ROWS * D * 2 <= WS_END, "ys overlay");
static_assert((size_t)YS_ROWS * DE * 2 <= (size_t)T * D * 4, "act fits d_out");
constexpr int CW_GCNT = 64;
constexpr int CW_BAR = 4096;

constexpr int LDS_RING = 131072, LDS_CTL_OFF = LDS_RING, LDS_BYTES = 147456;
constexpr int LC_ROWSQ = 0  , LC_HIST = 1024  , LC_BASE = 1152  , LC_TPFX = 1280  , LC_CNT = 1536  , LC_MISC = 1792;

__device__ __forceinline__ unsigned f2bf(float f) { unsigned u = __builtin_bit_cast(unsigned, f); return (u + 0x7fffu + ((u >> 16) & 1u)) >> 16; }
__device__ __forceinline__ unsigned pk2(float lo, float hi) { return f2bf(lo) | (f2bf(hi) << 16); }
__device__ __forceinline__ float bflo(unsigned w) { return __builtin_bit_cast(float, w << 16); }
__device__ __forceinline__ float bfhi(unsigned w) { return __builtin_bit_cast(float, w & 0xffff0000u); }
__device__ __forceinline__ float bf1(bf16 h) { return __builtin_bit_cast(float, ((unsigned)h) << 16); }
__device__ __forceinline__ u32x4 pack8(f32x4 a, f32x4 b) { u32x4 w; w.x = pk2(a[0], a[1]); w.y = pk2(a[2], a[3]); w.z = pk2(b[0], b[1]); w.w = pk2(b[2], b[3]); return w; }
__device__ __forceinline__ void unpack8(u32x4 w, f32x4& a, f32x4& b) { a = (f32x4){bflo(w.x), bfhi(w.x), bflo(w.y), bfhi(w.y)}; b = (f32x4){bflo(w.z), bfhi(w.z), bflo(w.w), bfhi(w.w)}; }
__device__ __forceinline__ float sigmoidf_(float x) { return __builtin_amdgcn_rcpf(1.0f + __expf(-x)); }
__device__ __forceinline__ f32x4 sig4(f32x4 v) { return (f32x4){sigmoidf_(v[0]), sigmoidf_(v[1]), sigmoidf_(v[2]), sigmoidf_(v[3])}; }
__device__ __forceinline__ float gelu_tanh(float y) { const float z = 1.5957691216057308f * (y + 0.044715f * y * y * y); return y * sigmoidf_(z); }
__device__ __forceinline__ float wave_sum(float v) {
#pragma unroll
    for (int o = 1; o < 64; o <<= 1) v += __shfl_xor(v, o);
    return v;
}
__device__ __forceinline__ double dexp(double x) {
    const double k = __builtin_rint(x * 1.4426950408889634074); const double r = (x - k * 0.693147180369123816490) - k * 1.90821492927058770002e-10;
    double p = 1.0 / 87178291200.0;
    p = p * r + 1.0 / 6227020800.0; p = p * r + 1.0 / 479001600.0; p = p * r + 1.0 / 39916800.0; p = p * r + 1.0 / 3628800.0; p = p * r + 1.0 / 362880.0; p = p * r + 1.0 / 40320.0;
    p = p * r + 1.0 / 5040.0; p = p * r + 1.0 / 720.0; p = p * r + 1.0 / 120.0; p = p * r + 1.0 / 24.0; p = p * r + 1.0 / 6.0; p = p * r + 0.5; p = p * r + 1.0; p = p * r + 1.0;
    const long long e = (long long)k + 1023; const double sc = __builtin_bit_cast(double, (unsigned long long)e << 52);
    return p * sc;
}
__device__ __forceinline__ void dsincos(double a, double& s, double& c) {
    const double k = __builtin_rint(a * 0.63661977236758134308); const double r = (a - k * 1.57079632673412561417) - k * 6.07710050650619224932e-11;
    const double r2 = r * r;
    double ps = -1.0 / 1307674368000.0; ps = ps * r2 + 1.0 / 6227020800.0; ps = ps * r2 - 1.0 / 39916800.0; ps = ps * r2 + 1.0 / 362880.0; ps = ps * r2 - 1.0 / 5040.0; ps = ps * r2 + 1.0 / 120.0; ps = ps * r2 - 1.0 / 6.0; ps = ps * r2 + 1.0;
    const double sn = ps * r;
    double pc = 1.0 / 20922789888000.0; pc = pc * r2 - 1.0 / 87178291200.0; pc = pc * r2 + 1.0 / 479001600.0; pc = pc * r2 - 1.0 / 3628800.0; pc = pc * r2 + 1.0 / 40320.0; pc = pc * r2 - 1.0 / 720.0; pc = pc * r2 + 1.0 / 24.0; pc = pc * r2 - 0.5; pc = pc * r2 + 1.0;
    const int q = ((int)k) & 3;
    s = (q == 0) ? sn : (q == 1) ? pc : (q == 2) ? -sn : -pc;
    c = (q == 0) ? pc : (q == 1) ? -sn : (q == 2) ? -pc : sn;
}

struct Ctx {
    LAS unsigned char* lds; int tid, lane, wave, vcu, G;
    const float *x, *c, *w_mod, *b_mod, *g1, *w_in, *b_in, *lam_re, *lam_im, *log_dt, *b_re, *b_im, *c_re, *c_im, *ssm_d, *w_glu, *b_glu, *pool_w, *pool_scale, *p_ssm, *p_pool, *w_out, *g2,
        *rc_w, *rc_b, *rf_w, *rf_b, *moe_g, *moe_u, *moe_d, *gf;
    float* out; unsigned char* ws;
    unsigned* ctl; float* mod; f32x2* lpow; f32x2* bbar; float* ktab; int* tokslot; int* sorted; float* slotw; float* logits;
    bf16 *WinT, *WgluT, *PssmT, *WeffT, *WoutT, *WrT, *W1T, *WdT, *TG, *EtT; float* ssum;
    bf16 *h1, *u2, *u, *UX, *upool, *Y, *Z, *Mb, *P, *Q, *act, *ys;
};

template <class RowA, class Epi>
__device__ __forceinline__ void gemm_unit_simple(const Ctx& X, RowA rowA, const bf16* Bt, int ldb, int K, const Epi& epi) {
    const int fr = X.lane & 15, fq = X.lane >> 4, w = X.wave;
    const bf16* a0 = rowA(32 * w + fr) + 8 * fq; const bf16* a1 = rowA(32 * w + 16 + fr) + 8 * fq;
    for (int np = 0; np < 8; ++np) {
        f32x4 acc00 = {0.f, 0.f, 0.f, 0.f}, acc01 = acc00, acc10 = acc00, acc11 = acc00;
        const bf16* b0 = Bt + (size_t)(32 * np + 8 * (fr >> 2) + (fr & 3)) * ldb + 8 * fq; const bf16* b1 = b0 + (size_t)4 * ldb;
        for (int k0 = 0; k0 < K; k0 += 32) {
            const bf16x8 A0 = *(const bf16x8*)(a0 + k0), A1 = *(const bf16x8*)(a1 + k0), B0 = *(const bf16x8*)(b0 + k0), B1 = *(const bf16x8*)(b1 + k0);
            acc00 = __builtin_amdgcn_mfma_f32_16x16x32_bf16(B0, A0, acc00, 0, 0, 0); acc01 = __builtin_amdgcn_mfma_f32_16x16x32_bf16(B1, A0, acc01, 0, 0, 0);
            acc10 = __builtin_amdgcn_mfma_f32_16x16x32_bf16(B0, A1, acc10, 0, 0, 0); acc11 = __builtin_amdgcn_mfma_f32_16x16x32_bf16(B1, A1, acc11, 0, 0, 0);
        }
        epi(32 * w + fr, 32 * np + 8 * fq, acc00, acc01); epi(32 * w + 16 + fr, 32 * np + 8 * fq, acc10, acc11);
    }
}

template <class NMap>
__device__ __forceinline__ void transpose_item(const float* W, int N, bf16* WT, int ldd, LAS float* scr, int k0, int n0, int lane, NMap nmap) {
#pragma unroll 8
    for (int i = 0; i < 32; ++i) { const int kk = 2 * i + (lane >> 5); scr[kk * 33 + (lane & 31)] = W[(size_t)(k0 + kk) * N + n0 + (lane & 31)]; }
    LDS_WAIT();
    const int c = lane & 7;
#pragma unroll
    for (int j = 0; j < 4; ++j) { const int n = (lane >> 3) + 8 * j; const LAS float* s = scr + (8 * c) * 33 + n;
        u32x4 o; o.x = pk2(s[0 * 33], s[1 * 33]); o.y = pk2(s[2 * 33], s[3 * 33]); o.z = pk2(s[4 * 33], s[5 * 33]); o.w = pk2(s[6 * 33], s[7 * 33]);
        *(u32x4*)(WT + (size_t)nmap(n0 + n) * ldd + k0 + 8 * c) = o; }
    LDS_WAIT();
}
struct NId { __device__ __forceinline__ int operator()(int n) const { return n; } };
struct NGateUp { int up; __device__ __forceinline__ int operator()(int a) const { return 8 * (a >> 2) + (a & 3) + 4 * up; } };

__device__ __forceinline__ void p0_prep(const Ctx& X) {
    const int gw = X.vcu * NWAVES + X.wave, NGW = X.G * NWAVES; const int gt = X.vcu * NTHR + X.tid, NGT = X.G * NTHR;
    {
        LAS float* cs = (LAS float*)X.lds;
        for (int cg = X.vcu; cg < NMOD / 32; cg += X.G) {
            __syncthreads();
            for (int i = X.tid; i < NB * D; i += NTHR) { const float v = X.c[i]; cs[i] = v * sigmoidf_(v); }
            __syncthreads();
            const int kq = X.tid >> 5, cl = X.tid & 31, col = cg * 32 + cl;
            float acc[NB];
#pragma unroll
            for (int b = 0; b < NB; ++b) acc[b] = 0.f;
            for (int k = kq * 64; k < kq * 64 + 64; ++k) { const float wv = X.w_mod[(size_t)k * NMOD + col];
#pragma unroll
                for (int b = 0; b < NB; ++b) acc[b] += cs[b * D + k] * wv; }
            __syncthreads();
#pragma unroll
            for (int b = 0; b < NB; ++b) cs[(kq * NB + b) * 32 + cl] = acc[b];
            __syncthreads();
            for (int o = X.tid; o < NB * 32; o += NTHR) { const int b = o >> 5, c2 = o & 31; float s = 0.f;
#pragma unroll
                for (int q = 0; q < 16; ++q) s += cs[(q * NB + b) * 32 + c2];
                X.mod[(size_t)b * NMOD + cg * 32 + c2] = s + X.b_mod[cg * 32 + c2]; }
        }
        __syncthreads();
    }
    {
        LAS float* scr = (LAS float*)(X.lds + X.wave * 16384);
        constexpr int I_IN = (D / 64) * (DIN / 32), I_GLU = (DSSM / 64) * (DSSM / 32), I_PS = (DSSM / 64) * (D / 32), I_WO = (D / 64) * (D / 32);
        constexpr int I_G = NE * (D / 64) * (DE / 32), I_D = NE * (DE / 64) * (D / 32);
        constexpr int NITEMS = I_IN + I_GLU + I_PS + I_WO + 2 * I_G + I_D;
        for (int it = gw; it < NITEMS; it += NGW) {
            int r = it;
            if (r < I_IN) { const int nb = DIN / 32; transpose_item(X.w_in, DIN, X.WinT, D, scr, 64 * (r / nb), 32 * (r % nb), X.lane, NId{}); continue; } r -= I_IN;
            if (r < I_GLU) { const int nb = DSSM / 32; transpose_item(X.w_glu, DSSM, X.WgluT, DSSM, scr, 64 * (r / nb), 32 * (r % nb), X.lane, NId{}); continue; } r -= I_GLU;
            if (r < I_PS) { const int nb = D / 32; transpose_item(X.p_ssm, D, X.PssmT, DSSM, scr, 64 * (r / nb), 32 * (r % nb), X.lane, NId{}); continue; } r -= I_PS;
            if (r < I_WO) { const int nb = D / 32; transpose_item(X.w_out, D, X.WoutT, D, scr, 64 * (r / nb), 32 * (r % nb), X.lane, NId{}); continue; } r -= I_WO;
            if (r < 2 * I_G) { const int up = r >= I_G; if (up) r -= I_G; const int per = (D / 64) * (DE / 32), e = r / per, q = r % per, nb = DE / 32;
                transpose_item((up ? X.moe_u : X.moe_g) + (size_t)e * D * DE, DE, X.W1T + (size_t)e * D * D, D, scr, 64 * (q / nb), 32 * (q % nb), X.lane, NGateUp{up}); continue; } r -= 2 * I_G;
            { const int per = (DE / 64) * (D / 32), e = r / per, q = r % per, nb = D / 32;
                transpose_item(X.moe_d + (size_t)e * DE * D, D, X.WdT + (size_t)e * D * DE, DE, scr, 64 * (q / nb), 32 * (q % nb), X.lane, NId{}); }
        }
    }
    for (int i = gt; i < 256 * D; i += NGT) { const int n = i >> 10, k = i & 1023; float v = 0.f; if (n < 4) v = X.rc_w[k * 4 + n]; else if (n < 36) v = X.rf_w[k * 32 + (n - 4)]; X.WrT[i] = (bf16)f2bf(v); }
    for (int i = gt; i < D * DPOOL; i += NGT) { const int n = i & 1023, gc = i >> 10, g = gc >> 7; const float* pw = X.pool_w + (size_t)gc * 128; float s = 0.f;
        for (int d = 0; d < 128; ++d) s += pw[d] * X.pool_scale[g * 128 + d] * X.p_pool[(size_t)(g * 128 + d) * D + n];
        X.WeffT[(size_t)n * DPOOL + gc] = (bf16)f2bf(s); }
    for (int i = gt; i < NG * NP; i += NGT) { const int g = i >> 6;
        const double dt = dexp((double)X.log_dt[g]), lr = (double)X.lam_re[i], li = (double)X.lam_im[i];
        const double mag = dexp(lr * dt); double sn, cs; dsincos(li * dt, sn, cs); const double br = mag * cs, bi = mag * sn;
        double wr = 1.0, wi = 0.0;
        for (int m = 0; m <= CH; ++m) { X.lpow[((size_t)g * 65 + m) * NP + (i & 63)] = (f32x2){(float)wr, (float)wi}; const double nr = wr * br - wi * bi; wi = wr * bi + wi * br; wr = nr; }
        const double den = lr * lr + li * li, nr1 = br - 1.0, fr_ = (nr1 * lr + bi * li) / den, fi_ = (bi * lr - nr1 * li) / den;
        for (int h = 0; h < GH; ++h) { const double b_r = (double)X.b_re[(size_t)i * GH + h], b_i = (double)X.b_im[(size_t)i * GH + h];
            X.bbar[(size_t)i * GH + h] = (f32x2){(float)(fr_ * b_r - fi_ * b_i), (float)(fr_ * b_i + fi_ * b_r)}; }
    }
    {
        LAS f32x2* lp = (LAS f32x2*)X.lds; LAS f32x2* bb = lp + 64;
        LAS double* fz = (LAS double*)(X.lds + 16384);
        for (int it = X.vcu; it < NG * CH; it += X.G) { const int g = it >> 6, m = it & 63;
            __syncthreads();
            if (X.tid < NP) { const int i = g * NP + X.tid; const double dt = dexp((double)X.log_dt[g]), lr = (double)X.lam_re[i], li = (double)X.lam_im[i];
                const double mag1 = dexp(lr * dt); double sn1, cs1; dsincos(li * dt, sn1, cs1); const double br = mag1 * cs1, bi = mag1 * sn1;
                const double den = lr * lr + li * li, nr1 = br - 1.0; fz[2 * X.tid] = (nr1 * lr + bi * li) / den; fz[2 * X.tid + 1] = (bi * lr - nr1 * li) / den;
                const double magm = dexp(lr * dt * m); double sn, cs; dsincos(li * dt * m, sn, cs); lp[X.tid] = (f32x2){(float)(magm * cs), (float)(magm * sn)}; }
            __syncthreads();
            for (int q = X.tid; q < NP * GH; q += NTHR) { const int p = q >> 4; const size_t i = (size_t)(g * NP) * GH + q; const double b_r = (double)X.b_re[i], b_i = (double)X.b_im[i], fr_ = fz[2 * p], fi_ = fz[2 * p + 1];
                bb[q] = (f32x2){(float)(fr_ * b_r - fi_ * b_i), (float)(fr_ * b_i + fi_ * b_r)}; }
            __syncthreads();
            if (X.tid < 256) { const int h = X.tid >> 4, h2 = X.tid & 15; float s = 0.f;
                for (int p = 0; p < NP; ++p) { const float cr = X.c_re[(size_t)(g * GH + h) * NP + p], ci = X.c_im[(size_t)(g * GH + h) * NP + p]; const f32x2 l = lp[p], b = bb[p * GH + h2];
                    const float tr = cr * l.x - ci * l.y, ti = cr * l.y + ci * l.x; s += tr * b.x - ti * b.y; }
                X.ktab[((size_t)(g * CH + m) * GH + h) * GH + h2] = s; }
        }
        __syncthreads();
    }
}

struct EpiInProj { bf16* UX; bf16* upool; const float* b_in; int tile, pn;
    __device__ __forceinline__ void operator()(int r, int c, f32x4 v0, f32x4 v1) const {
        const int col = pn * 256 + c, tok = tile * 256 + r;
        v0 += *(const f32x4*)(b_in + col); v1 += *(const f32x4*)(b_in + col + 4);
        bf16* dst;
        if (pn == 0) { const int g = col >> 4, h0 = col & 15, ci = tok >> 6, s = tok & 63; dst = UX + ((size_t)(g * NCOL + ci) * KX + 128 + s * 16 + h0); }
        else dst = upool + (size_t)tok * DPOOL + (col - DSSM);
        *(u32x4*)dst = pack8(v0, v1);
    } };

__device__ __forceinline__ void p1_rows(const Ctx& X, int tile) {
    const int b = tile >> 3; const float* md = X.mod + (size_t)b * NMOD;
    f32x4 sc[4], sh[4];
#pragma unroll
    for (int j = 0; j < 4; ++j) { const int c0 = 4 * X.lane + 256 * j; const f32x4 g = *(const f32x4*)(X.g1 + c0), s1 = *(const f32x4*)(md + D + c0); sc[j] = g * (s1 + 1.0f); sh[j] = *(const f32x4*)(md + c0); }
    for (int r = X.wave; r < 256; r += NWAVES) { const size_t tok = (size_t)tile * 256 + r; const f32x4* xr = (const f32x4*)(X.x + tok * D) + X.lane;
        f32x4 v[4]; float s = 0.f;
#pragma unroll
        for (int j = 0; j < 4; ++j) { v[j] = xr[64 * j]; s += (v[j].x * v[j].x + v[j].y * v[j].y) + (v[j].z * v[j].z + v[j].w * v[j].w); }
        const float rstd = 1.0f / sqrtf(wave_sum(s) * (1.0f / D) + EPS);
        u32x2* o = (u32x2*)(X.u + tok * D) + X.lane;
#pragma unroll
        for (int j = 0; j < 4; ++j) { const f32x4 y = v[j] * rstd * sc[j] + sh[j]; u32x2 w; w.x = pk2(y.x, y.y); w.y = pk2(y.z, y.w); o[64 * j] = w; }
    }
}
__device__ __forceinline__ void p1_tables(const Ctx& X) {
    const int gt = X.vcu * NTHR + X.tid, NGT = X.G * NTHR;
    for (int q = gt; q < NG * 1024 * (KX / 8); q += NGT) { const int kc = q % (KX / 8), row = q / (KX / 8), g = row >> 10, j = (row >> 4) & 63, h = row & 15, k0 = 8 * kc;
        float v[8];
        if (k0 < 128) {
#pragma unroll
            for (int i = 0; i < 8; ++i) { const int pp = k0 + i, p = pp & 63; const float cr = X.c_re[(size_t)(g * GH + h) * NP + p], ci = X.c_im[(size_t)(g * GH + h) * NP + p]; const f32x2 l = X.lpow[((size_t)g * 65 + j + 1) * NP + p];
                v[i] = (pp < 64) ? (cr * l.x - ci * l.y) : -(cr * l.y + ci * l.x); }
        } else { const int kk = k0 - 128, s = kk >> 4, h0 = kk & 15;
            if (s <= j) { const float* kt = X.ktab + ((size_t)(g * CH + (j - s)) * GH + h) * GH + h0;
#pragma unroll
                for (int i = 0; i < 8; ++i) v[i] = kt[i]; }
            else {
#pragma unroll
                for (int i = 0; i < 8; ++i) v[i] = 0.f; } }
        u32x4 w; w.x = pk2(v[0], v[1]); w.y = pk2(v[2], v[3]); w.z = pk2(v[4], v[5]); w.w = pk2(v[6], v[7]);
        *(u32x4*)(X.TG + (size_t)row * KX + k0) = w; }
    for (int q = gt; q < NG * 256 * 128; q += NGT) { const int kc = q & 127, row = q >> 7, g = row >> 8, pp = row & 255, k0 = 8 * kc, s = k0 >> 4, h0 = k0 & 15;
        float v[8];
        if (pp < 128) { const int p = pp & 63; const f32x2 l = X.lpow[((size_t)g * 65 + (63 - s)) * NP + p];
#pragma unroll
            for (int i = 0; i < 8; ++i) { const f32x2 b = X.bbar[(size_t)(g * NP + p) * GH + h0 + i]; v[i] = (pp < 64) ? (l.x * b.x - l.y * b.y) : (l.x * b.y + l.y * b.x); } }
        else {
#pragma unroll
            for (int i = 0; i < 8; ++i) v[i] = 0.f; }
        u32x4 w; w.x = pk2(v[0], v[1]); w.y = pk2(v[2], v[3]); w.z = pk2(v[4], v[5]); w.w = pk2(v[6], v[7]);
        *(u32x4*)(X.EtT + (size_t)row * 1024 + k0) = w; }
}
__device__ __forceinline__ void p1_inproj(const Ctx& X) {
    for (int tile = X.vcu; tile < T / 256; tile += X.G) {
        p1_rows(X, tile);
        WG_SYNC();
        for (int pn = 0; pn < 3; ++pn) {
            const bf16* A = X.u + (size_t)tile * 256 * D;
            gemm_unit_simple(X, [=](int r) { return A + (size_t)r * D; }, X.WinT + (size_t)pn * 256 * D, D, D, EpiInProj{X.UX, X.upool, X.b_in, tile, pn});
        }
    }
    p1_tables(X);
}

struct EpiSsum { float* S;
    __device__ __forceinline__ void operator()(int r, int c, f32x4 v0, f32x4 v1) const { if (c < 128) { *(f32x4*)(S + r * 128 + c) = v0; *(f32x4*)(S + r * 128 + c + 4) = v1; } } };
struct EpiS5Y { const bf16* UXg; bf16* Y; const float* dskip; int g, pmS, pnS;
    __device__ __forceinline__ void operator()(int r, int c, f32x4 v0, f32x4 v1) const {
        const int jl = c >> 4, h0 = c & 15, j = 16 * pnS + jl, ci = 256 * pmS + r;
        const u32x4 uw = *(const u32x4*)(UXg + (size_t)ci * KX + 128 + j * 16 + h0); f32x4 u0, u1; unpack8(uw, u0, u1);
        const f32x4 d0 = *(const f32x4*)(dskip + g * GH + h0), d1 = *(const f32x4*)(dskip + g * GH + h0 + 4);
        v0 += d0 * u0; v1 += d1 * u1;
#pragma unroll
        for (int i = 0; i < 4; ++i) { v0[i] = gelu_tanh(v0[i]); v1[i] = gelu_tanh(v1[i]); }
        *(u32x4*)(Y + ((size_t)ci * CH + j) * DSSM + g * GH + h0) = pack8(v0, v1);
    } };
__device__ __forceinline__ void p2_s5(const Ctx& X) {
    for (int id = X.vcu; id < 256; id += X.G) { const int g = id >> 4, pmS = (id >> 2) & 3, pnS = id & 3;
        bf16* UXg = X.UX + (size_t)g * NCOL * KX; const bf16* Arow = UXg + (size_t)(256 * pmS) * KX;
        float* S = X.ssum + (size_t)X.vcu * 256 * 128;
        gemm_unit_simple(X, [=](int r) { return Arow + (size_t)r * KX + 128; }, X.EtT + (size_t)g * 256 * 1024, 1024, 1024, EpiSsum{S});
        WG_SYNC();
        { const int bb = X.tid >> 6, p = X.tid & 63; const f32x2 L = X.lpow[((size_t)g * 65 + 64) * NP + p]; float sr = 0.f, si = 0.f;
            for (int c = 0; c < 32; ++c) { const int r = bb * 32 + c; bf16* row = UXg + (size_t)(256 * pmS + r) * KX; row[p] = (bf16)f2bf(sr); row[64 + p] = (bf16)f2bf(si);
                const float ar = S[r * 128 + p], ai = S[r * 128 + 64 + p]; const float nr = L.x * sr - L.y * si + ar; si = L.x * si + L.y * sr + ai; sr = nr; } }
        WG_SYNC();
        gemm_unit_simple(X, [=](int r) { return Arow + (size_t)r * KX; }, X.TG + (size_t)(g * 1024 + 256 * pnS) * KX, KX, 128 + 256 * (pnS + 1), EpiS5Y{UXg, X.Y, X.ssm_d, g, pmS, pnS});
        WG_SYNC();
    }
}

struct EpiGlu { const bf16* Y; bf16* Z; const float* b; int tile;
    __device__ __forceinline__ void operator()(int r, int c, f32x4 v0, f32x4 v1) const { const size_t o = (size_t)(tile * 256 + r) * DSSM + c;
        f32x4 y0, y1; unpack8(*(const u32x4*)(Y + o), y0, y1); v0 += *(const f32x4*)(b + c); v1 += *(const f32x4*)(b + c + 4);
        *(u32x4*)(Z + o) = pack8(y0 * sig4(v0), y1 * sig4(v1)); } };
struct EpiGate { bf16* O; const float* bias; int tile, pn;
    __device__ __forceinline__ void operator()(int r, int c, f32x4 v0, f32x4 v1) const { const int col = 256 * pn + c;
        v0 += *(const f32x4*)(bias + col); v1 += *(const f32x4*)(bias + col + 4);
        *(u32x4*)(O + (size_t)(tile * 256 + r) * D + col) = pack8(sig4(v0), sig4(v1)); } };
struct EpiMulP { bf16* P; int tile, pn;
    __device__ __forceinline__ void operator()(int r, int c, f32x4 v0, f32x4 v1) const { bf16* p = P + (size_t)(tile * 256 + r) * D + 256 * pn + c;
        f32x4 a, b; unpack8(*(const u32x4*)p, a, b); *(u32x4*)p = pack8(a * v0, b * v1); } };
struct EpiMerge { const bf16* P; bf16* Q; int tile, pn;
    __device__ __forceinline__ void operator()(int r, int c, f32x4 v0, f32x4 v1) const { const size_t o = (size_t)(tile * 256 + r) * D + 256 * pn + c;
        f32x4 a, b, q0, q1; unpack8(*(const u32x4*)(P + o), a, b); unpack8(*(const u32x4*)(Q + o), q0, q1); *(u32x4*)(Q + o) = pack8(a + q0 * v0, b + q1 * v1); } };
struct EpiWout { const float* x; const float* gate; bf16* h1; LAS float* rowsq; int tile, pn;
    __device__ __forceinline__ void operator()(int r, int c, f32x4 v0, f32x4 v1) const { const int col = 256 * pn + c; const size_t o = (size_t)(tile * 256 + r) * D + col;
        const f32x4 h0 = *(const f32x4*)(x + o) + *(const f32x4*)(gate + col) * v0, h1v = *(const f32x4*)(x + o + 4) + *(const f32x4*)(gate + col + 4) * v1;
        *(u32x4*)(h1 + o) = pack8(h0, h1v);
        float s = (h0[0] * h0[0] + h0[1] * h0[1]) + (h0[2] * h0[2] + h0[3] * h0[3]) + (h1v[0] * h1v[0] + h1v[1] * h1v[1]) + (h1v[2] * h1v[2] + h1v[3] * h1v[3]);
        s += __shfl_xor(s, 16); s += __shfl_xor(s, 32);
        if ((threadIdx.x & 63) < 16) atomicAdd((float*)(rowsq + r), s); } };
struct EpiRouter { float* logits; const float* cb; const float* fb; int tile;
    __device__ __forceinline__ void operator()(int r, int c, f32x4 v0, f32x4 v1) const { if (c < 40) { float* o = logits + (size_t)(tile * 256 + r) * 64 + c;
#pragma unroll
            for (int i = 0; i < 8; ++i) { const int n = c + i; const float bias = n < 4 ? cb[n] : (n < 36 ? fb[n - 4] : 0.f); o[i] = (i < 4 ? v0[i & 3] : v1[i & 3]) + bias; } } } };

__device__ __forceinline__ void p3_mixer(const Ctx& X) {
    LAS float* rowsq = (LAS float*)(X.lds + LDS_CTL_OFF + LC_ROWSQ); LAS unsigned* hist = (LAS unsigned*)(X.lds + LDS_CTL_OFF + LC_HIST); LAS unsigned* base = (LAS unsigned*)(X.lds + LDS_CTL_OFF + LC_BASE);
    for (int tile = X.vcu; tile < T / 256; tile += X.G) {
        const int b = tile >> 3, t0 = (tile & 7) * 256; const float* md = X.mod + (size_t)b * NMOD; const size_t tok0 = (size_t)tile * 256;
        if (X.tid < 256) rowsq[X.tid] = 0.f; if (X.tid < 32) hist[X.tid] = 0u;
        for (int q = X.tid; q < 256 * 64; q += NTHR) { const int r = q >> 6, ch0 = (q & 63) * 8, w = 2 << (ch0 >> 7), t = t0 + r, cnt = (t + 1 < w) ? t + 1 : w;
            const bf16* p = X.upool + (tok0 + r) * DPOOL + ch0; f32x4 s0 = {0.f, 0.f, 0.f, 0.f}, s1 = s0, c0, c1;
            unpack8(*(const u32x4*)p, c0, c1);
            for (int i = 0; i < cnt; ++i) { f32x4 a, bq; unpack8(*(const u32x4*)(p - (size_t)i * DPOOL), a, bq); s0 += a; s1 += bq; }
            const float inv = 1.0f / (float)cnt;
            *(u32x4*)(X.Mb + (tok0 + r) * DPOOL + ch0) = pack8(s0 * inv - c0, s1 * inv - c1); }
        { const bf16* A = X.Y + tok0 * DSSM; gemm_unit_simple(X, [=](int r) { return A + (size_t)r * DSSM; }, X.WgluT, DSSM, DSSM, EpiGlu{X.Y, X.Z, X.b_glu, tile}); }
        { const bf16* A = X.u + tok0 * D;
            for (int pn = 0; pn < 4; ++pn) gemm_unit_simple(X, [=](int r) { return A + (size_t)r * D; }, X.WinT + (size_t)(768 + 256 * pn) * D, D, D, EpiGate{X.P, X.b_in + 768, tile, pn});
            for (int pn = 0; pn < 4; ++pn) gemm_unit_simple(X, [=](int r) { return A + (size_t)r * D; }, X.WinT + (size_t)(1792 + 256 * pn) * D, D, D, EpiGate{X.Q, X.b_in + 1792, tile, pn}); }
        WG_SYNC();
        { const bf16* A = X.Z + tok0 * DSSM; for (int pn = 0; pn < 4; ++pn) gemm_unit_simple(X, [=](int r) { return A + (size_t)r * DSSM; }, X.PssmT + (size_t)(256 * pn) * DSSM, DSSM, DSSM, EpiMulP{X.P, tile, pn}); }
        { const bf16* A = X.Mb + tok0 * DPOOL; for (int pn = 0; pn < 4; ++pn) gemm_unit_simple(X, [=](int r) { return A + (size_t)r * DPOOL; }, X.WeffT + (size_t)(256 * pn) * DPOOL, DPOOL, DPOOL, EpiMerge{X.P, X.Q, tile, pn}); }
        WG_SYNC();
        { const bf16* A = X.Q + tok0 * D; for (int pn = 0; pn < 4; ++pn) gemm_unit_simple(X, [=](int r) { return A + (size_t)r * D; }, X.WoutT + (size_t)(256 * pn) * D, D, D, EpiWout{X.x, md + 2 * D, X.h1, rowsq, tile, pn}); }
        WG_SYNC();
        { f32x4 sc[4], sh[4];
#pragma unroll
            for (int j = 0; j < 2; ++j)
#pragma unroll
                for (int hlf = 0; hlf < 2; ++hlf) { const int c0 = 8 * X.lane + 512 * j + 4 * hlf; sc[2 * j + hlf] = *(const f32x4*)(X.g2 + c0) * (*(const f32x4*)(md + 4 * D + c0) + 1.0f); sh[2 * j + hlf] = *(const f32x4*)(md + 3 * D + c0); }
            for (int r = X.wave; r < 256; r += NWAVES) { const float rstd = 1.0f / sqrtf(rowsq[r] * (1.0f / D) + EPS); const bf16* hp = X.h1 + (tok0 + r) * D + 8 * X.lane; bf16* up = X.u2 + (tok0 + r) * D + 8 * X.lane;
#pragma unroll
                for (int j = 0; j < 2; ++j) { f32x4 a, bq; unpack8(*(const u32x4*)(hp + 512 * j), a, bq); *(u32x4*)(up + 512 * j) = pack8(a * rstd * sc[2 * j] + sh[2 * j], bq * rstd * sc[2 * j + 1] + sh[2 * j + 1]); } } }
        WG_SYNC();
        { const bf16* A = X.u2 + tok0 * D; gemm_unit_simple(X, [=](int r) { return A + (size_t)r * D; }, X.WrT, D, D, EpiRouter{X.logits, X.rc_b, X.rf_b, tile}); }
        WG_SYNC();
        int e0 = 0, e1 = 0; float w0 = 0.f, w1 = 0.f; unsigned rk0 = 0, rk1 = 0;
        if (X.tid < 256) { const float* lg = X.logits + (tok0 + X.tid) * 64;
            int grp = 0; float lm = lg[0];
#pragma unroll
            for (int j = 1; j < 4; ++j) { const float v = lg[j]; if (v > lm) { lm = v; grp = j; } }
            float se = 0.f;
#pragma unroll
            for (int j = 0; j < 4; ++j) se += __expf(lg[j] - lm);
            const float pg = 1.0f / se; const float* lf = lg + 4 + grp * 8;
            int i1 = 0; float l1 = lf[0];
#pragma unroll
            for (int j = 1; j < 8; ++j) { const float v = lf[j]; if (v > l1) { l1 = v; i1 = j; } }
            int i2 = -1; float l2 = -3.0e38f;
#pragma unroll
            for (int j = 0; j < 8; ++j) { const float v = lf[j]; if (j != i1 && v > l2) { l2 = v; i2 = j; } }
            const float ex = __expf(l2 - l1); w0 = pg / (1.0f + ex); w1 = pg * ex / (1.0f + ex); e0 = grp * 8 + i1; e1 = grp * 8 + i2;
            rk0 = atomicAdd((unsigned*)(hist + e0), 1u); rk1 = atomicAdd((unsigned*)(hist + e1), 1u); }
        __syncthreads();
        if (X.tid < 32) base[X.tid] = atomicAdd(X.ctl + CW_GCNT + X.tid, (unsigned)hist[X.tid]);
        __syncthreads();
        if (X.tid < 256) { const int tok = (int)tok0 + X.tid; const unsigned p0 = base[e0] + rk0, p1 = base[e1] + rk1;
            X.sorted[(size_t)e0 * CAP + p0] = tok; X.slotw[(size_t)e0 * CAP + p0] = w0; X.sorted[(size_t)e1 * CAP + p1] = tok; X.slotw[(size_t)e1 * CAP + p1] = w1;
            X.tokslot[2 * tok] = (e0 << 16) | (int)p0; X.tokslot[2 * tok + 1] = (e1 << 16) | (int)p1; }
        __syncthreads();
    }
}

__device__ __forceinline__ void moe_table(const Ctx& X) {
    LAS unsigned* tp = (LAS unsigned*)(X.lds + LDS_CTL_OFF + LC_TPFX); LAS unsigned* cnt = (LAS unsigned*)(X.lds + LDS_CTL_OFF + LC_CNT);
    __syncthreads();
    if (X.tid < 32) cnt[X.tid] = __hip_atomic_load(X.ctl + CW_GCNT + X.tid, __ATOMIC_RELAXED, __HIP_MEMORY_SCOPE_AGENT);
    __syncthreads();
    if (X.tid == 0) { unsigned s = 0; for (int e = 0; e < NE; ++e) { tp[e] = s; s += (cnt[e] + 255u) >> 8; } tp[NE] = s; }
    __syncthreads();
}
struct EpiAct { bf16* act; int row0, pn;
    __device__ __forceinline__ void operator()(int r, int c, f32x4 v0, f32x4 v1) const {
        f32x4 a;
#pragma unroll
        for (int i = 0; i < 4; ++i) a[i] = v0[i] * sigmoidf_(v0[i]) * v1[i];
        u32x2 w; w.x = pk2(a[0], a[1]); w.y = pk2(a[2], a[3]); *(u32x2*)(act + (size_t)(row0 + r) * DE + 128 * pn + (c >> 1)) = w; } };
struct EpiDown { bf16* ys; const float* sw; int row0, pos0, cnt, pn;
    __device__ __forceinline__ void operator()(int r, int c, f32x4 v0, f32x4 v1) const { const float w = (pos0 + r < cnt) ? sw[pos0 + r] : 0.f;
        *(u32x4*)(ys + (size_t)(row0 + r) * D + 256 * pn + c) = pack8(v0 * w, v1 * w); } };
__device__ __forceinline__ int find_expert(LAS unsigned* tp, unsigned mt) { int e = 0;
#pragma unroll 1
    for (int k = 1; k < NE; ++k) if (tp[k] <= mt) e = k;
    return e; }
__device__ __forceinline__ void p4_moe_up(const Ctx& X) {
    moe_table(X); LAS unsigned* tp = (LAS unsigned*)(X.lds + LDS_CTL_OFF + LC_TPFX); LAS unsigned* cnt = (LAS unsigned*)(X.lds + LDS_CTL_OFF + LC_CNT);
    const unsigned NU = tp[NE] * 4u;
    for (unsigned u = X.vcu; u < NU; u += X.G) { const unsigned mt = u >> 2; const int pn = u & 3, e = find_expert(tp, mt), lt = (int)(mt - tp[e]), c_e = (int)cnt[e];
        const int* st = X.sorted + (size_t)e * CAP + 256 * lt; const bf16* U2 = X.u2;
        gemm_unit_simple(X, [=](int r) { const int tok = (256 * lt + r < c_e) ? st[r] : 0; return U2 + (size_t)tok * D; }, X.W1T + ((size_t)e * D + 256 * pn) * D, D, D, EpiAct{X.act, (int)mt * 256, pn}); }
}
__device__ __forceinline__ void p5_moe_down(const Ctx& X) {
    moe_table(X); LAS unsigned* tp = (LAS unsigned*)(X.lds + LDS_CTL_OFF + LC_TPFX); LAS unsigned* cnt = (LAS unsigned*)(X.lds + LDS_CTL_OFF + LC_CNT);
    const unsigned NU = tp[NE] * 4u;
    for (unsigned u = X.vcu; u < NU; u += X.G) { const unsigned mt = u >> 2; const int pn = u & 3, e = find_expert(tp, mt), lt = (int)(mt - tp[e]), c_e = (int)cnt[e];
        const bf16* A = X.act + (size_t)mt * 256 * DE;
        gemm_unit_simple(X, [=](int r) { return A + (size_t)r * DE; }, X.WdT + ((size_t)e * D + 256 * pn) * DE, DE, DE, EpiDown{X.ys, X.slotw + (size_t)e * CAP, (int)mt * 256, 256 * lt, c_e, pn}); }
}
__device__ __forceinline__ void p6_final(const Ctx& X) {
    moe_table(X); LAS unsigned* tp = (LAS unsigned*)(X.lds + LDS_CTL_OFF + LC_TPFX);
    const int gw = X.vcu * NWAVES + X.wave, NGW = X.G * NWAVES;
    for (int tok = gw; tok < T; tok += NGW) { const int b = tok >> 11; const float* g2 = X.mod + (size_t)b * NMOD + 5 * D;
        const int s0 = X.tokslot[2 * tok], s1 = X.tokslot[2 * tok + 1]; const size_t r0 = (size_t)tp[s0 >> 16] * 256 + (s0 & 0xffff), r1 = (size_t)tp[s1 >> 16] * 256 + (s1 & 0xffff);
        f32x4 v[4]; float s = 0.f;
#pragma unroll
        for (int j = 0; j < 2; ++j) { const int c0 = 8 * X.lane + 512 * j; f32x4 h0, h1v, a0, a1, b0, b1;
            unpack8(*(const u32x4*)(X.h1 + (size_t)tok * D + c0), h0, h1v); unpack8(*(const u32x4*)(X.ys + r0 * D + c0), a0, a1); unpack8(*(const u32x4*)(X.ys + r1 * D + c0), b0, b1);
            v[2 * j] = h0 + *(const f32x4*)(g2 + c0) * (a0 + b0); v[2 * j + 1] = h1v + *(const f32x4*)(g2 + c0 + 4) * (a1 + b1);
#pragma unroll
            for (int q = 0; q < 2; ++q) { const f32x4 t = v[2 * j + q]; s += (t.x * t.x + t.y * t.y) + (t.z * t.z + t.w * t.w); } }
        const float rstd = 1.0f / sqrtf(wave_sum(s) * (1.0f / D) + EPS);
#pragma unroll
        for (int j = 0; j < 2; ++j)
#pragma unroll
            for (int q = 0; q < 2; ++q) { const int c0 = 8 * X.lane + 512 * j + 4 * q; *(f32x4*)(X.out + (size_t)tok * D + c0) = v[2 * j + q] * rstd * *(const f32x4*)(X.gf + c0); }
    }
}

struct Args { const float* in[31]; float* out; unsigned char* ws; int ph_lo, ph_hi; };
__global__ void __launch_bounds__(NTHR, 2) mk_fwd(Args a) {
    extern __shared__ __attribute__((aligned(16))) unsigned char lds_raw[];
    Ctx X;
    X.lds = (LAS unsigned char*)lds_raw; X.tid = threadIdx.x; X.lane = X.tid & 63; X.wave = __builtin_amdgcn_readfirstlane(X.tid >> 6);
    X.G = gridDim.x; { const int bx = blockIdx.x; X.vcu = (X.G % 8 == 0) ? (bx % 8) * (X.G / 8) + bx / 8 : bx; }
    X.x = a.in[0]; X.c = a.in[1]; X.w_mod = a.in[2]; X.b_mod = a.in[3]; X.g1 = a.in[4]; X.w_in = a.in[5]; X.b_in = a.in[6]; X.lam_re = a.in[7]; X.lam_im = a.in[8]; X.log_dt = a.in[9];
    X.b_re = a.in[10]; X.b_im = a.in[11]; X.c_re = a.in[12]; X.c_im = a.in[13]; X.ssm_d = a.in[14]; X.w_glu = a.in[15]; X.b_glu = a.in[16]; X.pool_w = a.in[17]; X.pool_scale = a.in[18];
    X.p_ssm = a.in[19]; X.p_pool = a.in[20]; X.w_out = a.in[21]; X.g2 = a.in[22]; X.rc_w = a.in[23]; X.rc_b = a.in[24]; X.rf_w = a.in[25]; X.rf_b = a.in[26];
    X.moe_g = a.in[27]; X.moe_u = a.in[28]; X.moe_d = a.in[29]; X.gf = a.in[30];
    X.out = a.out; X.ws = a.ws; unsigned char* ws = a.ws;
    X.ctl = (unsigned*)(ws + WS_CTL); X.mod = (float*)(ws + WS_MOD); X.lpow = (f32x2*)(ws + WS_LPOW); X.bbar = (f32x2*)(ws + WS_BBAR); X.ktab = (float*)(ws + WS_KTAB);
    X.tokslot = (int*)(ws + WS_TOKSLOT); X.sorted = (int*)(ws + WS_SORTED); X.slotw = (float*)(ws + WS_SLOTW); X.logits = (float*)(ws + WS_LOGITS);
    X.WinT = (bf16*)(ws + WS_WIN); X.WgluT = (bf16*)(ws + WS_WGLU); X.PssmT = (bf16*)(ws + WS_PSSM); X.WeffT = (bf16*)(ws + WS_WEFF); X.WoutT = (bf16*)(ws + WS_WOUT); X.WrT = (bf16*)(ws + WS_WR);
    X.W1T = (bf16*)(ws + WS_W1); X.WdT = (bf16*)(ws + WS_WD); X.TG = (bf16*)(ws + WS_TG); X.EtT = (bf16*)(ws + WS_ET); X.ssum = (float*)(ws + WS_SSUM);
    X.h1 = (bf16*)(ws + WS_H1); X.u2 = (bf16*)(ws + WS_U2); X.u = (bf16*)(ws + WS_U); X.UX = (bf16*)(ws + WS_UX); X.upool = (bf16*)(ws + WS_UPOOL); X.Y = (bf16*)(ws + WS_Y); X.Z = (bf16*)(ws + WS_Z); X.Mb = (bf16*)(ws + WS_M);
    X.P = (bf16*)a.out; X.Q = (bf16*)a.out + (size_t)T * D; X.act = (bf16*)a.out; X.ys = (bf16*)(ws + WS_YS);
    const int lo = a.ph_lo, hi = a.ph_hi;
#define IN(k) (lo <= (k) && (k) < hi)
    if (IN(0)) p0_prep(X);
    if (IN(1)) p1_inproj(X);
    if (IN(2)) p2_s5(X);
    if (IN(3)) p3_mixer(X);
    if (IN(4)) p4_moe_up(X);
    if (IN(5)) p5_moe_down(X);
    if (IN(6)) p6_final(X);
#undef IN
}

extern "C" void kernel_launch(void* const* d_in, const int* in_sizes, int n_in, void* d_out, int out_size, void* d_ws, size_t ws_size, hipStream_t stream) {
    static int grid = 0;
    if (grid == 0) {
        if (n_in != 31 || out_size != T * D || ws_size < WS_END) { fprintf(stderr, "kernel_launch: unexpected shapes (n_in %d out %d ws %zu)\n", n_in, out_size, ws_size); grid = -1; return; }
        int dev = 0, cus = 0;
        if (hipGetDevice(&dev) != hipSuccess || hipDeviceGetAttribute(&cus, hipDeviceAttributeMultiprocessorCount, dev) != hipSuccess) { grid = -1; return; }
        if (hipFuncSetAttribute((const void*)mk_fwd, hipFuncAttributeMaxDynamicSharedMemorySize, LDS_BYTES) != hipSuccess) { fprintf(stderr, "kernel_launch: hipFuncSetAttribute failed\n"); grid = -1; return; }
        grid = cus;
    }
    if (grid < 0) return;
    (void)hipMemsetAsync((char*)d_ws + WS_CTL, 0, CTL_ZERO_BYTES, stream);
    Args a{};
    for (int i = 0; i < 31; ++i) a.in[i] = (const float*)d_in[i];
    a.out = (float*)d_out; a.ws = (unsigned char*)d_ws;
    for (int li = 0; li < MK_N_LAUNCHES; ++li) {
        a.ph_lo = (MK_N_LAUNCHES == 7) ? li : 0; a.ph_hi = (MK_N_LAUNCHES == 7) ? li + 1 : 7;
        hipLaunchKernelGGL(mk_fwd, dim3(grid), dim3(NTHR), LDS_BYTES, stream, a);
    }
}
```

```cpp
#include <hip/hip_runtime.h>
#include <cstdio>

#ifndef MK_N_LAUNCHES
#define MK_N_LAUNCHES 1
#endif

#define GAS __attribute__((address_space(1)))
#define LAS __attribute__((address_space(3)))
typedef unsigned short bf16;
typedef short bf16x8 __attribute__((ext_vector_type(8)));
typedef float f32x4 __attribute__((ext_vector_type(4)));
typedef float f32x2 __attribute__((ext_vector_type(2)));
typedef unsigned u32x4 __attribute__((ext_vector_type(4)));
typedef int i32x4 __attribute__((ext_vector_type(4)));
typedef unsigned u32x2 __attribute__((ext_vector_type(2)));
#define LDS_WAIT() asm volatile("s_waitcnt lgkmcnt(0)" ::: "memory")
#define VM_WAIT() asm volatile("s_waitcnt vmcnt(0)" ::: "memory")
#define WG_SYNC() do { asm volatile("s_waitcnt vmcnt(0) lgkmcnt(0)" ::: "memory"); __syncthreads(); } while (0)

constexpr int D = 1024, NB = 32, SEQ = 2048, T = NB * SEQ, DIN = 2816, DSSM = 256, DPOOL = 512;
constexpr int NG = 16, GH = 16, NP = 64, CH = 16  , CHGH = CH * GH  , NCOL = T / CH  , NCHB = SEQ / CH  , KX = 128 + CHGH  ;
constexpr int NE = 32, DE = 512, CAP = 65536, NMOD = 6 * D;
constexpr int YS_ROWS = 2 * T + NE * 256;
constexpr float EPS = 1e-6f;
constexpr int NWAVES = 8, NTHR = 512;

constexpr size_t MiB = 1u << 20;
constexpr size_t WS_CTL = 0, CTL_ZERO_BYTES = 1 * MiB;
constexpr size_t WS_MOD = 1 * MiB, WS_LPOW = 2 * MiB, WS_BBAR = 3 * MiB, WS_KTAB = 4 * MiB, WS_TOKSLOT = 5 * MiB, WS_SORTED = 6 * MiB, WS_SLOTW = 14 * MiB, WS_LOGITS = 22 * MiB;
constexpr size_t WS_WIN = 38 * MiB, WS_WGLU = 44 * MiB, WS_PSSM = 45 * MiB, WS_WEFF = 47 * MiB, WS_WOUT = 49 * MiB, WS_WR = 51 * MiB, WS_W1 = 52 * MiB, WS_WD = 116 * MiB;
constexpr size_t WS_TG = 148 * MiB, WS_ET = 184 * MiB, WS_SSUM = 192 * MiB, WS_H1 = 224 * MiB, WS_U2 = 352 * MiB;
constexpr size_t WS_U = 480 * MiB, WS_UX = 608 * MiB  , WS_UPOOL = 656 * MiB, WS_YZM = 720 * MiB, WS_U2F8 = 848 * MiB  , WS_U8 = 912 * MiB  , WS_WG8 = 976 * MiB  , WS_END = 978 * MiB;
constexpr size_t WS_YS = WS_U;
static_assert(WS_YS + (size_t)YS_ROWS * D * 2 <= WS_U2F8, "ys overlay");
static_assert((size_t)YS_ROWS * DE * 2 <= (size_t)T * D * 4, "act fits d_out");
constexpr int CW_GCNT = 64;
constexpr int CW_BAR = 4096;

constexpr int LDS_RING = 131072, LDS_CTL_OFF = 135168  , LDS_BYTES = 147456;
constexpr int LC_ROWSQ = 0  , LC_HIST = 1024  , LC_BASE = 1152  , LC_TPFX = 1280  , LC_CNT = 1536  , LC_MISC = 1792, LC_ULIST = 2048  ;

__device__ __forceinline__ unsigned f2bf(float f) { unsigned u = __builtin_bit_cast(unsigned, f); return (u + 0x7fffu + ((u >> 16) & 1u)) >> 16; }
typedef __bf16 bf16v2 __attribute__((ext_vector_type(2)));
__device__ __forceinline__ unsigned pk2(float lo, float hi) { const f32x2 v = {lo, hi}; return __builtin_bit_cast(unsigned, __builtin_convertvector(v, bf16v2)); }
__device__ __forceinline__ float bflo(unsigned w) { return __builtin_bit_cast(float, w << 16); }
__device__ __forceinline__ float bfhi(unsigned w) { return __builtin_bit_cast(float, w & 0xffff0000u); }
__device__ __forceinline__ float bf1(bf16 h) { return __builtin_bit_cast(float, ((unsigned)h) << 16); }
__device__ __forceinline__ u32x4 pack8(f32x4 a, f32x4 b) { u32x4 w; w.x = pk2(a[0], a[1]); w.y = pk2(a[2], a[3]); w.z = pk2(b[0], b[1]); w.w = pk2(b[2], b[3]); return w; }
__device__ __forceinline__ void unpack8(u32x4 w, f32x4& a, f32x4& b) { a = (f32x4){bflo(w.x), bfhi(w.x), bflo(w.y), bfhi(w.y)}; b = (f32x4){bflo(w.z), bfhi(w.z), bflo(w.w), bfhi(w.w)}; }
constexpr float W8_SCALE = 16.f, A8_SCALE = 4.f, Y8_SCALE = 16.f;
__device__ __forceinline__ unsigned pk4f8(f32x4 v) { int r = __builtin_amdgcn_cvt_pk_fp8_f32(v[0], v[1], 0, false); r = __builtin_amdgcn_cvt_pk_fp8_f32(v[2], v[3], r, true); return (unsigned)r; }
__device__ __forceinline__ void unpack8f8(u32x2 w, f32x4& a, f32x4& b) { const f32x2 a0 = __builtin_amdgcn_cvt_pk_f32_fp8((int)w.x, false), a1 = __builtin_amdgcn_cvt_pk_f32_fp8((int)w.x, true), b0 = __builtin_amdgcn_cvt_pk_f32_fp8((int)w.y, false), b1 = __builtin_amdgcn_cvt_pk_f32_fp8((int)w.y, true);
    a = (f32x4){a0[0], a0[1], a1[0], a1[1]}; b = (f32x4){b0[0], b0[1], b1[0], b1[1]}; }
__device__ __forceinline__ float sigmoidf_(float x) { return __builtin_amdgcn_rcpf(1.0f + __expf(-x)); }
__device__ __forceinline__ f32x4 sig4(f32x4 v) { return (f32x4){sigmoidf_(v[0]), sigmoidf_(v[1]), sigmoidf_(v[2]), sigmoidf_(v[3])}; }
__device__ __forceinline__ float gelu_tanh(float y) { const float z = 1.5957691216057308f * (y + 0.044715f * y * y * y); return y * sigmoidf_(z); }
__device__ __forceinline__ float wave_sum(float v) {
#pragma unroll
    for (int o = 1; o < 64; o <<= 1) v += __shfl_xor(v, o);
    return v;
}
__device__ __forceinline__ double dexp(double x) {
    const double k = __builtin_rint(x * 1.4426950408889634074); const double r = (x - k * 0.693147180369123816490) - k * 1.90821492927058770002e-10;
    double p = 1.0 / 87178291200.0;
    p = p * r + 1.0 / 6227020800.0; p = p * r + 1.0 / 479001600.0; p = p * r + 1.0 / 39916800.0; p = p * r + 1.0 / 3628800.0; p = p * r + 1.0 / 362880.0; p = p * r + 1.0 / 40320.0;
    p = p * r + 1.0 / 5040.0; p = p * r + 1.0 / 720.0; p = p * r + 1.0 / 120.0; p = p * r + 1.0 / 24.0; p = p * r + 1.0 / 6.0; p = p * r + 0.5; p = p * r + 1.0; p = p * r + 1.0;
    const long long e = (long long)k + 1023; const double sc = __builtin_bit_cast(double, (unsigned long long)e << 52);
    return p * sc;
}
__device__ __forceinline__ void dsincos(double a, double& s, double& c) {
    const double k = __builtin_rint(a * 0.63661977236758134308); const double r = (a - k * 1.57079632673412561417) - k * 6.07710050650619224932e-11;
    const double r2 = r * r;
    double ps = -1.0 / 1307674368000.0; ps = ps * r2 + 1.0 / 6227020800.0; ps = ps * r2 - 1.0 / 39916800.0; ps = ps * r2 + 1.0 / 362880.0; ps = ps * r2 - 1.0 / 5040.0; ps = ps * r2 + 1.0 / 120.0; ps = ps * r2 - 1.0 / 6.0; ps = ps * r2 + 1.0;
    const double sn = ps * r;
    double pc = 1.0 / 20922789888000.0; pc = pc * r2 - 1.0 / 87178291200.0; pc = pc * r2 + 1.0 / 479001600.0; pc = pc * r2 - 1.0 / 3628800.0; pc = pc * r2 + 1.0 / 40320.0; pc = pc * r2 - 1.0 / 720.0; pc = pc * r2 + 1.0 / 24.0; pc = pc * r2 - 0.5; pc = pc * r2 + 1.0;
    const int q = ((int)k) & 3;
    s = (q == 0) ? sn : (q == 1) ? pc : (q == 2) ? -sn : -pc;
    c = (q == 0) ? pc : (q == 1) ? -sn : (q == 2) ? -pc : sn;
}


__device__ __forceinline__ int lane_now() { int l = (int)__builtin_amdgcn_mbcnt_hi(~0u, __builtin_amdgcn_mbcnt_lo(~0u, 0u)); asm volatile("" : "+v"(l)); return l; }
#define XB_TMO      128
#define XB_XCNT(j)  (256  + 64 * (j))
#define XB_XSUB(j)  (1280 + 64 * (j))
#define XB_XGEN(j)  (2304 + 64 * (j))
#define XB_TOP      3328
#define XB_TOPGEN   3392
#define XCD_BAR_WORDS 3456
#define XB_SPIN_CAP (1u << 20)
__device__ __forceinline__ unsigned xb_ld(unsigned* p)              { return __hip_atomic_load(p, __ATOMIC_RELAXED, __HIP_MEMORY_SCOPE_AGENT); }
__device__ __forceinline__ unsigned xb_add(unsigned* p, unsigned v) { return __hip_atomic_fetch_add(p, v, __ATOMIC_RELAXED, __HIP_MEMORY_SCOPE_AGENT); }
__device__ __forceinline__ unsigned xb_xcc_id() { return (unsigned)__builtin_amdgcn_s_getreg((3 << 11) | 20) & 0xFu; }
#define XB_SPIN(cond, bar) do { unsigned _sp = 0; while (cond) { __builtin_amdgcn_s_sleep(1); \
    if ((++_sp & 255u) == 0u) { if (xb_ld(&(bar)[XB_TMO])) break; if (_sp > XB_SPIN_CAP) { atomicAdd(&(bar)[XB_TMO], 1u); break; } } } } while (0)
struct XcdBarrier { unsigned* bar; unsigned x; volatile LAS unsigned* st; int wave; };
__device__ __forceinline__ XcdBarrier xcd_barrier_post(unsigned* bar, volatile LAS unsigned* st, int wave) {
    XcdBarrier b; b.bar = bar; b.x = xb_xcc_id(); b.st = st; b.wave = wave;
    if (wave == 0 && lane_now() == 0) (void)xb_add(&bar[XB_XCNT(b.x)], 1u);
    return b;
}
__device__ __forceinline__ void xcd_barrier_complete(unsigned* bar, unsigned x, unsigned& nloc, unsigned& nx) {
    const unsigned G = gridDim.x * gridDim.y * gridDim.z;
    unsigned sum, cnt, mine, sp = 0u;
    for (;;) {
        sum = 0u; cnt = 0u; mine = 0u;
#pragma unroll
        for (unsigned j = 0; j < 16; ++j) { const unsigned c = xb_ld(&bar[XB_XCNT(j)]); sum += c; cnt += (c > 0u) ? 1u : 0u; mine = (j == x) ? c : mine; }
        if (sum == G) break;
        __builtin_amdgcn_s_sleep(1);
        if ((++sp & 255u) == 0u) { if (xb_ld(&bar[XB_TMO])) break; if (sp > XB_SPIN_CAP) { atomicAdd(&bar[XB_TMO], 1u); break; } }
    }
    nloc = mine > 0u ? mine : 1u; nx = cnt > 0u ? cnt : 1u;
}
__device__ __forceinline__ void xcd_barrier(const XcdBarrier& b) {
    asm volatile("s_waitcnt vmcnt(0)" ::: "memory");
    __syncthreads();
    if (b.wave == 0 && lane_now() == 0) {
        unsigned* bar = b.bar;
        __builtin_amdgcn_s_waitcnt(0);
        unsigned nloc = b.st[0], nx = b.st[1];
        if (nloc == 0u) { xcd_barrier_complete(bar, b.x, nloc, nx); b.st[0] = nloc; b.st[1] = nx; }
        const unsigned old = xb_add(&bar[XB_XSUB(b.x)], 1u);
        const unsigned gen = old / nloc;
        if (old + 1u == (gen + 1u) * nloc) {
            __builtin_amdgcn_fence(__ATOMIC_RELEASE, "agent");
            asm volatile("s_waitcnt vmcnt(0)" ::: "memory");
            const unsigned og = xb_add(&bar[XB_TOP], 1u);
            const unsigned tg = og / nx;
            if (og + 1u == (tg + 1u) * nx) xb_add(&bar[XB_TOPGEN], 1u);
            else XB_SPIN(xb_ld(&bar[XB_TOPGEN]) == tg, bar);
            __builtin_amdgcn_fence(__ATOMIC_ACQUIRE, "agent");
            xb_add(&bar[XB_XGEN(b.x)], 1u);
            asm volatile("s_waitcnt vmcnt(0)" ::: "memory");
        } else {
            XB_SPIN(xb_ld(&bar[XB_XGEN(b.x)]) == gen, bar);
            __builtin_amdgcn_fence(__ATOMIC_ACQUIRE, "agent");
            asm volatile("s_waitcnt vmcnt(0)" ::: "memory");
        }
    }
    __syncthreads();
}

struct Ctx {
    LAS unsigned char* lds; int wave, vcu, G;
    const float *x, *c, *w_mod, *b_mod, *g1, *w_in, *b_in, *lam_re, *lam_im, *log_dt, *b_re, *b_im, *c_re, *c_im, *ssm_d, *w_glu, *b_glu, *pool_w, *pool_scale, *p_ssm, *p_pool, *w_out, *g2,
        *rc_w, *rc_b, *rf_w, *rf_b, *moe_g, *moe_u, *moe_d, *gf;
    float* out; unsigned char* ws;
    unsigned* ctl; float* mod; f32x2* lpow; f32x2* bbar; float* ktab; int* tokslot; int* sorted; float* slotw; float* logits;
    bf16 *WinT, *WgluT, *PssmT, *WeffT, *WoutT, *WrB, *W1T, *WdT, *TG, *EtT; float* ssum; float* cbias;
    bf16 *h1, *u2, *u, *UX, *upool, *YZM, *P, *Q, *act, *ys; unsigned char *u2f8, *u8, *Wg8;
};

namespace pg8 {
constexpr int BM = 256, BK = 64, HALF = 128, HTB = HALF * BK * 2, STAGE_BYTES = 8 * HTB;
__device__ __forceinline__ int lds_byte(int r, int c) { const int st = (r >> 4) * 2 + (c >> 5), rr = r & 15, cc = c & 31, ob = rr * 64 + cc * 2; return st * 1024 + (ob ^ (((ob >> 9) & 1) << 5)); }
__device__ __forceinline__ void stage_rc(int b, int& R, int& C) { const int st = b / 1024, sb = b % 1024, swz = sb ^ (((sb >> 9) & 1) << 5); R = (st >> 1) * 16 + swz / 64; C = (st & 1) * 32 + (swz % 64) / 2; }
__device__ __forceinline__ int perm32(int rho) { const int n = rho >> 4, i = rho & 15; return 8 * (i >> 2) + 4 * n + (i & 3); }
struct Unit { const char* A; const char* B; const char* B1; int nt; int i0, i1, i2, i3; };

template <class Epi, class Sched, bool GATHER, bool ALIGN_EPI, bool SP2, bool F8 = false>
__device__ __forceinline__ void gemm_phase(LAS unsigned char* lds, const int wave, const int lda, const int ldb, const Sched& S, const Epi& E, const bool pre = false, const bool fol = false, const Unit* fu = nullptr, const int lda_f = 0, const int ldb_f = 0) {
    const int lane = lane_now(), wid = wave, tid = wid * 64 + lane, wr = wid >> 2, wc = wid & 3, fr = lane & 15, fq = lane >> 4;
    int RA[2], CA[2]; unsigned voffB[2], voffA[2][2], voffN[2][2];
#pragma unroll
    for (int i = 0; i < 2; ++i) { int R, C; stage_rc(tid * 16 + i * 8192, R, C); RA[i] = R; CA[i] = C; const int Rb = (R & ~31) + perm32(R & 31); voffB[i] = (unsigned)(Rb * ldb + C) * 2u;
        voffA[0][i] = (unsigned)(R * lda + C) * 2u; voffA[1][i] = (unsigned)((R + HALF) * lda + C) * 2u; voffN[0][i] = voffA[0][i]; voffN[1][i] = voffA[1][i]; }
    unsigned voffBf[2] = {0u, 0u}, voffAf[2][2] = {{0u, 0u}, {0u, 0u}};
    if (fol) {
#pragma unroll
        for (int i = 0; i < 2; ++i) { const int R = RA[i], C = CA[i], Rb = (R & ~31) + perm32(R & 31); voffBf[i] = (unsigned)(Rb * ldb_f + C) * 2u; voffAf[0][i] = (unsigned)(R * lda_f + C) * 2u; voffAf[1][i] = (unsigned)((R + HALF) * lda_f + C) * 2u; } }
    const size_t kstep = (size_t)(BK * 2);
    const unsigned ldsw = (unsigned)wid * 1024u;
    const int aoff = lds_byte(wr * 64 + fr, fq * 8), boff = lds_byte(wc * 32 + fr, fq * 8);
#define PG8_SA(b, h) (((b) * 2 + (h)) * HTB)
#define PG8_SB(b, h) ((4 + (b) * 2 + (h)) * HTB)
#define PG8_STAGE(bufoff, gbase, voff) do { const char* _gb = (const char*)(gbase); asm volatile("" : "+s"(_gb)); _Pragma("unroll") for (int _i = 0; _i < 2; ++_i) \
        __builtin_amdgcn_global_load_lds((const unsigned*)(_gb + (voff)[_i]), (LAS unsigned*)(lds + (bufoff) + ldsw + _i * 8192), 16, 0, 0); } while (0)
#define PG8_LD16(p) (*(const LAS i32x4_t*)(p))
#define PG8_LDA(dst, b, h) do { if constexpr (F8) { _Pragma("unroll") for (int m = 0; m < 4; ++m) { const i32x4_t _l = PG8_LD16(lds + PG8_SA(b, h) + aoff + m * 2048), _h = PG8_LD16(lds + PG8_SA(b, h) + aoff + m * 2048 + 1024); dst##8[m] = __builtin_shufflevector(_l, _h, 0, 1, 2, 3, 4, 5, 6, 7); } } \
        else { _Pragma("unroll") for (int m = 0; m < 4; ++m) _Pragma("unroll") for (int k = 0; k < 2; ++k) dst[m][k] = *(const LAS bf16x8*)(lds + PG8_SA(b, h) + aoff + m * 2048 + k * 1024); } } while (0)
#define PG8_LDB(dst, b, h) do { if constexpr (F8) { _Pragma("unroll") for (int n = 0; n < 2; ++n) { const i32x4_t _l = PG8_LD16(lds + PG8_SB(b, h) + boff + n * 2048), _h = PG8_LD16(lds + PG8_SB(b, h) + boff + n * 2048 + 1024); dst##8[n] = __builtin_shufflevector(_l, _h, 0, 1, 2, 3, 4, 5, 6, 7); } } \
        else { _Pragma("unroll") for (int n = 0; n < 2; ++n) _Pragma("unroll") for (int k = 0; k < 2; ++k) dst[n][k] = *(const LAS bf16x8*)(lds + PG8_SB(b, h) + boff + n * 2048 + k * 1024); } } while (0)
#define PG8_MMA(ai, bj, At, Bt) do { __builtin_amdgcn_s_setprio(1); if constexpr (F8) { _Pragma("unroll") for (int m = 0; m < 4; ++m) _Pragma("unroll") for (int n = 0; n < 2; ++n) \
        asm volatile("v_mfma_scale_f32_16x16x128_f8f6f4 %0, %1, %2, %0, %3, %3 op_sel_hi:[0,0,0]" : "+v"(acc[ai][bj][m][n]) : "v"(Bt##8[n]), "v"(At##8[m]), "v"(sc127)); } \
        else { _Pragma("unroll") for (int m = 0; m < 4; ++m) _Pragma("unroll") for (int n = 0; n < 2; ++n) _Pragma("unroll") for (int k = 0; k < 2; ++k) \
        acc[ai][bj][m][n] = __builtin_amdgcn_mfma_f32_16x16x32_bf16(Bt[n][k], At[m][k], acc[ai][bj][m][n], 0, 0, 0); } __builtin_amdgcn_s_setprio(0); } while (0)
#define PG8_WAIT_V(n) asm volatile("s_waitcnt vmcnt(" #n ")" ::: "memory")
#define PG8_WAIT_L(n) asm volatile("s_waitcnt lgkmcnt(" #n ")" ::: "memory")
#define PG8_BAR __builtin_amdgcn_s_barrier()
#define PG8_SCHED __builtin_amdgcn_sched_barrier(0)
    Unit cur, nxt; int ui = 0;
    if (!S.next(0, cur)) return;
    f32x4 acc[2][2][4][2];
#pragma unroll
    for (int a = 0; a < 2; ++a)
#pragma unroll
        for (int b = 0; b < 2; ++b)
#pragma unroll
            for (int m = 0; m < 4; ++m)
#pragma unroll
                for (int n = 0; n < 2; ++n) acc[a][b][m][n] = (f32x4){0.f, 0.f, 0.f, 0.f};
    typedef int i32x4_t __attribute__((ext_vector_type(4))); typedef int i32x8_t __attribute__((ext_vector_type(8)));
    bf16x8 At[4][2], B0[2][2], B1[2][2]; i32x8_t At8[4], B08[2], B18[2]; int sc127 = 0x7f7f7f7f; asm volatile("" : "+v"(sc127));
    if constexpr (GATHER) {
#pragma unroll
        for (int h = 0; h < 2; ++h)
#pragma unroll
            for (int i = 0; i < 2; ++i) voffA[h][i] = S.row_off(cur, RA[i] + h * HALF) + (unsigned)CA[i] * 2u;
        asm volatile("s_waitcnt vmcnt(0)" ::: "memory");
    }
    const char* cA = cur.A; const char* cB = cur.B; const char* cB1 = cur.B1;
    if (pre) { if (wr == 1) PG8_BAR; }
    else if constexpr (SP2) {
        PG8_STAGE(PG8_SB(0, 0), cB, voffB); PG8_STAGE(PG8_SB(0, 1), cB1, voffB); PG8_STAGE(PG8_SA(0, 0), cA, voffA[0]); PG8_STAGE(PG8_SA(0, 1), cA, voffA[1]);
        if (wr == 1) PG8_BAR;
        PG8_WAIT_V(2); PG8_BAR;
        PG8_STAGE(PG8_SB(1, 0), cB + kstep, voffB); PG8_STAGE(PG8_SA(1, 0), cA + kstep, voffA[0]); PG8_STAGE(PG8_SB(1, 1), cB1 + kstep, voffB);
        PG8_WAIT_V(6); PG8_BAR;
    } else {
        PG8_STAGE(PG8_SB(0, 0), cB, voffB); PG8_STAGE(PG8_SA(0, 0), cA, voffA[0]); PG8_STAGE(PG8_SB(0, 1), cB1, voffB); PG8_STAGE(PG8_SA(0, 1), cA, voffA[1]);
        if (wr == 1) PG8_BAR;
        PG8_WAIT_V(4); PG8_BAR;
        PG8_STAGE(PG8_SB(1, 0), cB + kstep, voffB); PG8_STAGE(PG8_SA(1, 0), cA + kstep, voffA[0]); PG8_STAGE(PG8_SB(1, 1), cB1 + kstep, voffB);
        PG8_WAIT_V(6); PG8_BAR;
    }
    for (;;) {
        const bool has_next = S.next(ui + 1, nxt);
        if constexpr (GATHER) {
            if (has_next) {
#pragma unroll
                for (int h = 0; h < 2; ++h)
#pragma unroll
                    for (int i = 0; i < 2; ++i) voffN[h][i] = S.row_off(nxt, RA[i] + h * HALF) + (unsigned)CA[i] * 2u;
            } else {
#pragma unroll
                for (int h = 0; h < 2; ++h)
#pragma unroll
                    for (int i = 0; i < 2; ++i) voffN[h][i] = voffA[h][i];
            }
            asm volatile("s_waitcnt vmcnt(0)" : "+v"(voffN[0][0]), "+v"(voffN[0][1]), "+v"(voffN[1][0]), "+v"(voffN[1][1]) :: "memory");
        }
        const bool usef = fol && !has_next;
        const char* nA = has_next ? nxt.A : (usef ? fu->A : cA); const char* nB = has_next ? nxt.B : (usef ? fu->B : cB); const char* nB1 = has_next ? nxt.B1 : (usef ? fu->B1 : cB1);
        const int nt = cur.nt;
        for (int t = 0; t < nt; t += 2) {
            const bool last = (t == nt - 2);
            const char* a1 = cA + (size_t)(t + 1) * kstep;
            const char* a2 = last ? nA : cA + (size_t)(t + 2) * kstep; const char* b2 = last ? nB : cB + (size_t)(t + 2) * kstep;
            const char* a3 = a2 + kstep; const char* b3 = b2 + kstep;
            const char* b2h = last ? nB1 : cB1 + (size_t)(t + 2) * kstep; const char* b3h = b2h + kstep;
            unsigned vA2[2][2];
#pragma unroll
            for (int h = 0; h < 2; ++h)
#pragma unroll
                for (int i = 0; i < 2; ++i) vA2[h][i] = (GATHER && last) ? voffN[h][i] : ((usef && last) ? voffAf[h][i] : voffA[h][i]);
            unsigned vB2[2];
#pragma unroll
            for (int i = 0; i < 2; ++i) vB2[i] = (usef && last) ? voffBf[i] : voffB[i];
            if constexpr (SP2) {
            PG8_LDB(B0, 0, 0); PG8_LDB(B1, 0, 1); PG8_SCHED; PG8_LDA(At, 0, 0); PG8_STAGE(PG8_SA(1, 1), a1, voffA[1]);
            PG8_WAIT_V(8); PG8_WAIT_L(0); PG8_BAR; PG8_MMA(0, 0, At, B0); PG8_MMA(0, 1, At, B1); PG8_BAR; PG8_SCHED;
            PG8_LDA(At, 0, 1); PG8_STAGE(PG8_SB(0, 0), b2, vB2); PG8_STAGE(PG8_SB(0, 1), b2h, vB2); PG8_STAGE(PG8_SA(0, 0), a2, vA2[0]);
            PG8_WAIT_V(8); PG8_WAIT_L(0); PG8_BAR; PG8_MMA(1, 0, At, B0); PG8_MMA(1, 1, At, B1); PG8_BAR; PG8_SCHED;
            PG8_LDB(B0, 1, 0); PG8_LDB(B1, 1, 1); PG8_SCHED; PG8_LDA(At, 1, 0); PG8_STAGE(PG8_SA(0, 1), a2, vA2[1]);
            PG8_WAIT_V(8); PG8_WAIT_L(0); PG8_BAR; PG8_MMA(0, 0, At, B0); PG8_MMA(0, 1, At, B1); PG8_BAR; PG8_SCHED;
            PG8_LDA(At, 1, 1); PG8_STAGE(PG8_SB(1, 0), b3, vB2); PG8_STAGE(PG8_SB(1, 1), b3h, vB2); PG8_STAGE(PG8_SA(1, 0), a3, vA2[0]);
            PG8_WAIT_V(8); PG8_WAIT_L(0); PG8_BAR; PG8_MMA(1, 0, At, B0); PG8_MMA(1, 1, At, B1); PG8_BAR; PG8_SCHED;
            } else {
            PG8_LDB(B0, 0, 0); PG8_SCHED; PG8_LDA(At, 0, 0); PG8_STAGE(PG8_SA(1, 1), a1, voffA[1]);
            PG8_WAIT_L(8); PG8_BAR; PG8_WAIT_L(0); PG8_MMA(0, 0, At, B0); PG8_BAR; PG8_SCHED;
            PG8_LDB(B1, 0, 1); PG8_STAGE(PG8_SB(0, 0), b2, voffB);
            PG8_BAR; PG8_WAIT_L(0); PG8_MMA(0, 1, At, B1); PG8_BAR;
            PG8_LDA(At, 0, 1); PG8_STAGE(PG8_SA(0, 0), a2, vA2[0]);
            PG8_BAR; PG8_WAIT_L(0); PG8_MMA(1, 0, At, B0); PG8_BAR; PG8_SCHED;
            PG8_STAGE(PG8_SB(0, 1), b2h, voffB);
            PG8_WAIT_V(6); PG8_BAR; PG8_MMA(1, 1, At, B1); PG8_BAR;
            PG8_LDB(B0, 1, 0); PG8_SCHED; PG8_LDA(At, 1, 0); PG8_STAGE(PG8_SA(0, 1), a2, vA2[1]);
            PG8_WAIT_L(8); PG8_BAR; PG8_WAIT_L(0); PG8_MMA(0, 0, At, B0); PG8_BAR; PG8_SCHED;
            PG8_LDB(B1, 1, 1); PG8_STAGE(PG8_SB(1, 0), b3, voffB);
            PG8_BAR; PG8_WAIT_L(0); PG8_MMA(0, 1, At, B1); PG8_BAR;
            PG8_LDA(At, 1, 1); PG8_STAGE(PG8_SA(1, 0), a3, vA2[0]);
            PG8_BAR; PG8_WAIT_L(0); PG8_MMA(1, 0, At, B0); PG8_BAR; PG8_SCHED;
            PG8_STAGE(PG8_SB(1, 1), b3h, voffB);
            PG8_WAIT_V(6); PG8_BAR; PG8_MMA(1, 1, At, B1); PG8_BAR;
            }
        }
        if constexpr (F8) asm volatile("s_nop 15\n\ts_nop 15" ::: "memory");
        if constexpr (ALIGN_EPI) { if (wr == 0) PG8_BAR; }
        { int r0 = wr * 64 + fr, c0 = wc * 32 + 8 * fq; asm volatile("" : "+v"(r0), "+v"(c0));
        typename Epi::Col colv[2];
        colv[0] = E.col(cur, c0); if constexpr (!Epi::PAIR) colv[1] = E.col(cur, HALF + c0);
#pragma unroll
        for (int ai = 0; ai < 2; ++ai)
#pragma unroll
            for (int mb = 0; mb < 4; mb += Epi::MB) {
                if constexpr (Epi::PAIR) {
                    typename Epi::Pre pre[Epi::MB];
#pragma unroll
                    for (int m = 0; m < Epi::MB; ++m) pre[m] = E.pre(cur, ai * HALF + (mb + m) * 16 + r0, c0);
#pragma unroll
                    for (int m = 0; m < Epi::MB; ++m) E.pair(cur, ai * HALF + (mb + m) * 16 + r0, c0, acc[ai][0][mb + m][0], acc[ai][0][mb + m][1], acc[ai][1][mb + m][0], acc[ai][1][mb + m][1], pre[m], colv[0]);
                } else {
                typename Epi::Pre pre[Epi::MB][2];
#pragma unroll
                for (int m = 0; m < Epi::MB; ++m)
#pragma unroll
                    for (int bj = 0; bj < 2; ++bj) pre[m][bj] = E.pre(cur, ai * HALF + (mb + m) * 16 + r0, bj * HALF + c0);
#pragma unroll
                for (int m = 0; m < Epi::MB; ++m)
#pragma unroll
                    for (int bj = 0; bj < 2; ++bj) E(cur, ai * HALF + (mb + m) * 16 + r0, bj * HALF + c0, acc[ai][bj][mb + m][0], acc[ai][bj][mb + m][1], pre[m][bj], colv[bj]);
                }
                asm volatile("" ::: "memory"); } }
        if (!has_next) break;
#pragma unroll
        for (int a = 0; a < 2; ++a)
#pragma unroll
            for (int b = 0; b < 2; ++b)
#pragma unroll
                for (int m = 0; m < 4; ++m)
#pragma unroll
                    for (int n = 0; n < 2; ++n) acc[a][b][m][n] = (f32x4){0.f, 0.f, 0.f, 0.f};
        cur = nxt; cA = nA; cB = nB; cB1 = nB1; ++ui;
        if constexpr (GATHER) {
#pragma unroll
            for (int h = 0; h < 2; ++h)
#pragma unroll
                for (int i = 0; i < 2; ++i) voffA[h][i] = voffN[h][i];
        }
        if constexpr (ALIGN_EPI) { if (wr == 1) PG8_BAR; }
    }
    PG8_WAIT_V(0);
    if constexpr (!ALIGN_EPI) { if (wr == 0) PG8_BAR; }
    PG8_BAR;
#undef PG8_SA
#undef PG8_SB
#undef PG8_STAGE
#undef PG8_LD16
#undef PG8_LDA
#undef PG8_LDB
#undef PG8_MMA
#undef PG8_WAIT_V
#undef PG8_WAIT_L
#undef PG8_BAR
#undef PG8_SCHED
}
}
#ifndef PG8_SP2
#define PG8_SP2 true
#endif
#ifndef PG8_ALIGN
#define PG8_ALIGN true
#endif

template <class NMap>
__device__ __forceinline__ void transpose_item(const float* W, int N, bf16* WT, int ldd, LAS float* scr, int k0, int n0, int lane, NMap nmap) {
    f32x4 v[16];
#pragma unroll
    for (int i = 0; i < 16; ++i) v[i] = *(const f32x4*)(W + (size_t)(k0 + 4 * i + (lane >> 4)) * N + n0 + 4 * (lane & 15));
#pragma unroll
    for (int i = 0; i < 16; ++i) { LAS float* d = scr + (4 * i + (lane >> 4)) * 65 + 4 * (lane & 15); d[0] = v[i].x; d[1] = v[i].y; d[2] = v[i].z; d[3] = v[i].w; }
    LDS_WAIT();
    const int c = lane & 7;
#pragma unroll
    for (int j = 0; j < 8; ++j) { const int n = (lane >> 3) + 8 * j; const LAS float* q = scr + (8 * c) * 65 + n;
        u32x4 o; o.x = pk2(q[0 * 65], q[1 * 65]); o.y = pk2(q[2 * 65], q[3 * 65]); o.z = pk2(q[4 * 65], q[5 * 65]); o.w = pk2(q[6 * 65], q[7 * 65]);
        *(u32x4*)(WT + (size_t)nmap(n0 + n) * ldd + k0 + 8 * c) = o; }
    LDS_WAIT();
}
template <class NMap>
__device__ __forceinline__ void transpose_item_f8(const float* W, int N, unsigned char* WT, int ldd, LAS float* scr, int k0, int n0, int lane, NMap nmap) {
    f32x4 v[16];
#pragma unroll
    for (int i = 0; i < 16; ++i) v[i] = *(const f32x4*)(W + (size_t)(k0 + 4 * i + (lane >> 4)) * N + n0 + 4 * (lane & 15));
#pragma unroll
    for (int i = 0; i < 16; ++i) { LAS float* d = scr + (4 * i + (lane >> 4)) * 65 + 4 * (lane & 15); d[0] = v[i].x; d[1] = v[i].y; d[2] = v[i].z; d[3] = v[i].w; }
    LDS_WAIT();
    const int c = lane & 7;
#pragma unroll
    for (int j = 0; j < 8; ++j) { const int n = (lane >> 3) + 8 * j; const LAS float* q = scr + (8 * c) * 65 + n;
        u32x2 o; o.x = pk4f8((f32x4){q[0 * 65], q[1 * 65], q[2 * 65], q[3 * 65]} * W8_SCALE); o.y = pk4f8((f32x4){q[4 * 65], q[5 * 65], q[6 * 65], q[7 * 65]} * W8_SCALE);
        *(u32x2*)(WT + (size_t)nmap(n0 + n) * ldd + k0 + 8 * c) = o; }
    LDS_WAIT();
}
struct NId { __device__ __forceinline__ int operator()(int n) const { return n; } };
struct NSub { int off; __device__ __forceinline__ int operator()(int n) const { return n - off; } };
struct NGateUp { int up; __device__ __forceinline__ int operator()(int a) const { return a + DE * up; } };

__device__ __forceinline__ void p0_prep(const Ctx& X) {
    const int gw = X.vcu * NWAVES + X.wave, NGW = X.G * NWAVES; const int gt = X.vcu * NTHR + (X.wave * 64 + lane_now()), NGT = X.G * NTHR;
    {
        LAS float* red = (LAS float*)X.lds;
        const int lane = lane_now(), fr = lane & 15, fq = lane >> 4, w = X.wave;
        for (int cg = X.vcu; cg < NMOD / 32; cg += X.G) {
            f32x4 acc[2][2];
#pragma unroll
            for (int a = 0; a < 2; ++a)
#pragma unroll
                for (int b = 0; b < 2; ++b) acc[a][b] = (f32x4){0.f, 0.f, 0.f, 0.f};
#pragma unroll 1
            for (int ks = 0; ks < 4; ++ks) { const int k0 = 128 * w + 32 * ks + 8 * fq;
                bf16x8 whi[2], wlo[2], chi[2], clo[2];
#pragma unroll
                for (int h = 0; h < 2; ++h) { float wv[8], cv[8];
#pragma unroll
                    for (int j = 0; j < 8; ++j) wv[j] = X.w_mod[(size_t)(k0 + j) * NMOD + cg * 32 + 16 * h + fr];
                    const f32x4 c0 = *(const f32x4*)(X.c + (size_t)(16 * h + fr) * D + k0), c1 = *(const f32x4*)(X.c + (size_t)(16 * h + fr) * D + k0 + 4);
#pragma unroll
                    for (int j = 0; j < 4; ++j) { cv[j] = c0[j] * sigmoidf_(c0[j]); cv[4 + j] = c1[j] * sigmoidf_(c1[j]); }
#pragma unroll
                    for (int j = 0; j < 8; ++j) { const unsigned hw = f2bf(wv[j]), hc = f2bf(cv[j]); whi[h][j] = (short)hw; chi[h][j] = (short)hc;
                        wlo[h][j] = (short)f2bf(wv[j] - __builtin_bit_cast(float, hw << 16)); clo[h][j] = (short)f2bf(cv[j] - __builtin_bit_cast(float, hc << 16)); } }
#pragma unroll
                for (int a = 0; a < 2; ++a)
#pragma unroll
                    for (int b = 0; b < 2; ++b) { acc[a][b] = __builtin_amdgcn_mfma_f32_16x16x32_bf16(whi[a], chi[b], acc[a][b], 0, 0, 0);
                        acc[a][b] = __builtin_amdgcn_mfma_f32_16x16x32_bf16(whi[a], clo[b], acc[a][b], 0, 0, 0); acc[a][b] = __builtin_amdgcn_mfma_f32_16x16x32_bf16(wlo[a], chi[b], acc[a][b], 0, 0, 0); } }
            __syncthreads();
#pragma unroll
            for (int a = 0; a < 2; ++a)
#pragma unroll
                for (int b = 0; b < 2; ++b)
#pragma unroll
                    for (int r = 0; r < 4; ++r) red[(w * 32 + 16 * a + 4 * fq + r) * 32 + 16 * b + fr] = acc[a][b][r];
            __syncthreads();
            for (int o = w * 64 + lane; o < NB * 32; o += NTHR) { const int n = o >> 5, b = o & 31; float sm = 0.f;
#pragma unroll
                for (int q = 0; q < 8; ++q) sm += red[(q * 32 + n) * 32 + b];
                X.mod[(size_t)b * NMOD + cg * 32 + n] = sm + X.b_mod[cg * 32 + n]; }
        }
        __syncthreads();
    }
    {
        LAS float* scr = (LAS float*)(X.lds + X.wave * 16640);
        constexpr int I_IN = (D / 64) * (DIN / 64), I_GLU = (DSSM / 64) * (DSSM / 64), I_PS = (DSSM / 64) * (D / 64), I_WO = (D / 64) * (D / 64), I_G8 = (D / 64) * (2048 / 64);
        constexpr int NITEMS = I_IN + I_GLU + I_PS + I_WO + I_G8;
        for (int it = gw; it < NITEMS; it += NGW) {
            int r = it;
            if (r < I_IN) { const int nb = DIN / 64; transpose_item(X.w_in, DIN, X.WinT, D, scr, 64 * (r / nb), 64 * (r % nb), lane_now(), NId{}); continue; } r -= I_IN;
            if (r < I_GLU) { const int nb = DSSM / 64; transpose_item(X.w_glu, DSSM, X.WgluT, D, scr, 64 * (r / nb), 64 * (r % nb), lane_now(), NId{}); continue; } r -= I_GLU;
            if (r < I_PS) { const int nb = D / 64; transpose_item(X.p_ssm, D, X.PssmT, D, scr, 64 * (r / nb), 64 * (r % nb), lane_now(), NId{}); continue; } r -= I_PS;
            if (r < I_WO) { const int nb = D / 64; transpose_item(X.w_out, D, X.WoutT, D, scr, 64 * (r / nb), 64 * (r % nb), lane_now(), NId{}); continue; } r -= I_WO;
            { const int nb = 2048 / 64; transpose_item_f8(X.w_in, DIN, X.Wg8, D, scr, 64 * (r / nb), 768 + 64 * (r % nb), lane_now(), NSub{768}); }
        }
    }
    for (int i = gt; i < (D / 4) * DPOOL; i += NGT) { const int n4 = (i & 255) * 4, gc = i >> 8, g = gc >> 7; const float* pw = X.pool_w + (size_t)gc * 128;
        float s0 = 0.f, s1 = 0.f, s2 = 0.f, s3 = 0.f;
#pragma unroll 1
        for (int d0 = 0; d0 < 128; d0 += 16) { float4 pv[16];
#pragma unroll
            for (int j = 0; j < 16; ++j) pv[j] = *(const float4*)(X.p_pool + (size_t)(g * 128 + d0 + j) * D + n4);
#pragma unroll
            for (int j = 0; j < 16; ++j) { const float w = pw[d0 + j] * X.pool_scale[g * 128 + d0 + j];
                s0 += w * pv[j].x; s1 += w * pv[j].y; s2 += w * pv[j].z; s3 += w * pv[j].w; } }
        X.WeffT[(size_t)(n4 + 0) * D + gc] = (bf16)f2bf(s0); X.WeffT[(size_t)(n4 + 1) * D + gc] = (bf16)f2bf(s1);
        X.WeffT[(size_t)(n4 + 2) * D + gc] = (bf16)f2bf(s2); X.WeffT[(size_t)(n4 + 3) * D + gc] = (bf16)f2bf(s3); }
    for (int i = gt; i < NG * NP; i += NGT) { const int g = i >> 6;
        const double dt = dexp((double)X.log_dt[g]), lr = (double)X.lam_re[i], li = (double)X.lam_im[i];
        const double mag = dexp(lr * dt); double sn, cs; dsincos(li * dt, sn, cs); const double br = mag * cs, bi = mag * sn;
        double wr = 1.0, wi = 0.0;
        for (int m = 0; m <= CH; ++m) { X.lpow[((size_t)g * 65 + m) * NP + (i & 63)] = (f32x2){(float)wr, (float)wi}; const double nr = wr * br - wi * bi; wi = wr * bi + wi * br; wr = nr; }
        const double den = lr * lr + li * li, nr1 = br - 1.0, fr_ = (nr1 * lr + bi * li) / den, fi_ = (bi * lr - nr1 * li) / den;
        for (int h = 0; h < GH; ++h) { const double b_r = (double)X.b_re[(size_t)i * GH + h], b_i = (double)X.b_im[(size_t)i * GH + h];
            X.bbar[(size_t)i * GH + h] = (f32x2){(float)(fr_ * b_r - fi_ * b_i), (float)(fr_ * b_i + fi_ * b_r)}; }
    }
    {
        LAS f32x2* lp = (LAS f32x2*)X.lds; LAS f32x2* bb = lp + 64;
        LAS double* fz = (LAS double*)(X.lds + 16384);
        for (int it = X.vcu; it < NG * CH; it += X.G) { const int g = it / CH, m = it % CH;
            __syncthreads();
            if ((X.wave * 64 + lane_now()) < NP) { const int i = g * NP + (X.wave * 64 + lane_now()); const double dt = dexp((double)X.log_dt[g]), lr = (double)X.lam_re[i], li = (double)X.lam_im[i];
                const double mag1 = dexp(lr * dt); double sn1, cs1; dsincos(li * dt, sn1, cs1); const double br = mag1 * cs1, bi = mag1 * sn1;
                const double den = lr * lr + li * li, nr1 = br - 1.0; fz[2 * (X.wave * 64 + lane_now())] = (nr1 * lr + bi * li) / den; fz[2 * (X.wave * 64 + lane_now()) + 1] = (bi * lr - nr1 * li) / den;
                const double magm = dexp(lr * dt * m); double sn, cs; dsincos(li * dt * m, sn, cs); lp[(X.wave * 64 + lane_now())] = (f32x2){(float)(magm * cs), (float)(magm * sn)}; }
            __syncthreads();
            for (int q = (X.wave * 64 + lane_now()); q < NP * GH; q += NTHR) { const int p = q >> 4; const size_t i = (size_t)(g * NP) * GH + q; const double b_r = (double)X.b_re[i], b_i = (double)X.b_im[i], fr_ = fz[2 * p], fi_ = fz[2 * p + 1];
                bb[q] = (f32x2){(float)(fr_ * b_r - fi_ * b_i), (float)(fr_ * b_i + fi_ * b_r)}; }
            __syncthreads();
            if ((X.wave * 64 + lane_now()) < 256) { const int h = (X.wave * 64 + lane_now()) >> 4, h2 = (X.wave * 64 + lane_now()) & 15; float s = 0.f;
                for (int p0 = 0; p0 < NP; p0 += 16) { float crv[16], civ[16];
#pragma unroll
                    for (int j = 0; j < 16; ++j) { crv[j] = X.c_re[(size_t)(g * GH + h) * NP + p0 + j]; civ[j] = X.c_im[(size_t)(g * GH + h) * NP + p0 + j]; }
#pragma unroll
                    for (int j = 0; j < 16; ++j) { const f32x2 l = lp[p0 + j], b = bb[(p0 + j) * GH + h2]; const float tr = crv[j] * l.x - civ[j] * l.y, ti = crv[j] * l.y + civ[j] * l.x; s += tr * b.x - ti * b.y; } }
                X.ktab[((size_t)(g * CH + m) * GH + h) * GH + h2] = s; }
        }
        __syncthreads();
    }
}

#ifndef FAST_P1
#define FAST_P1 1
#endif
#ifndef FAST_P2
#define FAST_P2 1
#endif
#ifndef FAST_P3
#define FAST_P3 1
#endif
#ifndef FAST_P4
#define FAST_P4 1
#endif
#ifndef FAST_P5
#define FAST_P5 1
#endif
using pg8::Unit;
template <bool FAST, bool GATHER, class Epi, class Sched, bool F8 = false>
__device__ __forceinline__ void run_gemm(const Ctx& X, int lda, int ldb, const Sched& S, const Epi& E, const bool pre = false, const bool fol = false, const Unit* fu = nullptr, const int lda_f = 0, const int ldb_f = 0) {
    static_assert(FAST, "the checkpoint (simple) GEMM core was removed from this build");
    pg8::gemm_phase<Epi, Sched, GATHER, PG8_ALIGN, PG8_SP2, F8>(X.lds, X.wave, lda, ldb, S, E, pre, fol, fu, lda_f, ldb_f);
}
struct SchedTileN { const char* A; const char* B; size_t bstep; int n, nt; size_t bhalf;
    __device__ __forceinline__ bool next(int i, Unit& u) const { if (i >= n) return false; u.A = A; u.B = B + (size_t)i * bstep; u.B1 = u.B + bhalf; u.nt = nt; u.i0 = i; u.i1 = 0; u.i2 = 0; u.i3 = 0; return true; }
    __device__ __forceinline__ unsigned row_off(const Unit&, int) const { return 0u; } };

struct NoPre {};
struct EpiInProj { bf16* UX; bf16* upool; const float* b_in; int tile;
    static constexpr int MB = 4; static constexpr bool PAIR = false;
    typedef NoPre Pre; struct Col { f32x4 b0, b1; };
    __device__ __forceinline__ Col col(const Unit& u, int c) const { const int cc = u.i0 * 256 + c; return Col{*(const f32x4*)(b_in + cc), *(const f32x4*)(b_in + cc + 4)}; }
    __device__ __forceinline__ Pre pre(const Unit&, int, int) const { return Pre{}; }
    __device__ __forceinline__ void operator()(const Unit& u, int r, int c, f32x4 v0, f32x4 v1, const Pre&, const Col& k) const {
        const int pn = u.i0, col = pn * 256 + c, tok = tile * 256 + r;
        v0 += k.b0; v1 += k.b1;
        bf16* dst;
        if (pn == 0) { const int g = col >> 4, h0 = col & 15, ci = tok / CH, s = tok % CH; dst = UX + ((size_t)(g * NCOL + ci) * KX + 128 + s * 16 + h0); }
        else dst = upool + (size_t)tok * DPOOL + (col - DSSM);
        *(u32x4*)dst = pack8(v0, v1);
    } };

__device__ __forceinline__ void p1_rows(const Ctx& X, int tile) {
    const int b = tile >> 3; const float* md = X.mod + (size_t)b * NMOD;
    f32x4 sc[4], sh[4];
#pragma unroll
    for (int j = 0; j < 4; ++j) { const int c0 = 4 * lane_now() + 256 * j; const f32x4 g = *(const f32x4*)(X.g1 + c0), s1 = *(const f32x4*)(md + D + c0); sc[j] = g * (s1 + 1.0f); sh[j] = *(const f32x4*)(md + c0); }
    for (int r4 = X.wave; r4 < 256; r4 += 4 * NWAVES) {
        f32x4 v[4][4];
#pragma unroll
        for (int k = 0; k < 4; ++k) { const f32x4* xr = (const f32x4*)(X.x + ((size_t)tile * 256 + r4 + 8 * k) * D) + lane_now();
#pragma unroll
            for (int j = 0; j < 4; ++j) v[k][j] = xr[64 * j]; }
#pragma unroll
        for (int k = 0; k < 4; ++k) { float s = 0.f;
#pragma unroll
            for (int j = 0; j < 4; ++j) s += (v[k][j].x * v[k][j].x + v[k][j].y * v[k][j].y) + (v[k][j].z * v[k][j].z + v[k][j].w * v[k][j].w);
            const float rstd = 1.0f / sqrtf(wave_sum(s) * (1.0f / D) + EPS);
            u32x2* o = (u32x2*)(X.u + ((size_t)tile * 256 + r4 + 8 * k) * D) + lane_now();
            unsigned* o8 = (unsigned*)(X.u8 + ((size_t)tile * 256 + r4 + 8 * k) * D) + lane_now();
#pragma unroll
            for (int j = 0; j < 4; ++j) { const f32x4 y = v[k][j] * rstd * sc[j] + sh[j]; u32x2 w; w.x = pk2(y.x, y.y); w.y = pk2(y.z, y.w); o[64 * j] = w; o8[64 * j] = pk4f8(y * A8_SCALE); } }
    }
}
__device__ __forceinline__ void p1_tables(const Ctx& X) {
    const int gt = X.vcu * NTHR + (X.wave * 64 + lane_now()), NGT = X.G * NTHR;
    for (int q = gt; q < NG * CHGH * CH; q += NGT) { const int s_ = q % CH, row = q / CH, g = row / CHGH, j = (row >> 4) % CH, h = row & 15, m = (s_ <= j) ? (j - s_) : 0;
        const f32x4* kt = (const f32x4*)(X.ktab + ((size_t)(g * CH + m) * GH + h) * GH); const float ok = (s_ <= j) ? 1.f : 0.f;
        const f32x4 v0 = kt[0], v1 = kt[1], v2 = kt[2], v3 = kt[3];
        u32x4* o = (u32x4*)(X.TG + (size_t)row * KX + 128 + s_ * 16); o[0] = pack8(v0 * ok, v1 * ok); o[1] = pack8(v2 * ok, v3 * ok); }
    for (int q = gt; q < NG * CHGH * 16; q += NGT) { const int kc = q & 15, row = q >> 4, g = row / CHGH, j = (row >> 4) % CH, h = row & 15, k0 = 8 * kc;
        float v[8];
#pragma unroll
        for (int i = 0; i < 8; ++i) { const int pp = k0 + i, p = pp & 63; const float cr = X.c_re[(size_t)(g * GH + h) * NP + p], ci = X.c_im[(size_t)(g * GH + h) * NP + p]; const f32x2 l = X.lpow[((size_t)g * 65 + j + 1) * NP + p];
            v[i] = (pp < 64) ? (cr * l.x - ci * l.y) : -(cr * l.y + ci * l.x); }
        u32x4 w; w.x = pk2(v[0], v[1]); w.y = pk2(v[2], v[3]); w.z = pk2(v[4], v[5]); w.w = pk2(v[6], v[7]);
        *(u32x4*)(X.TG + (size_t)row * KX + k0) = w; }
    for (int q = gt; q < NG * 256 * (CHGH / 8); q += NGT) { const int kc = q % (CHGH / 8), row = q / (CHGH / 8), g = row >> 8, pp = row & 255, k0 = 8 * kc, s = k0 >> 4, h0 = k0 & 15;
        float v[8];
        if (pp < 128) { const int p = pp & 63; const f32x2 l = X.lpow[((size_t)g * 65 + (CH - 1 - s)) * NP + p];
#pragma unroll
            for (int i = 0; i < 8; ++i) { const f32x2 b = X.bbar[(size_t)(g * NP + p) * GH + h0 + i]; v[i] = (pp < 64) ? (l.x * b.x - l.y * b.y) : (l.x * b.y + l.y * b.x); } }
        else {
#pragma unroll
            for (int i = 0; i < 8; ++i) v[i] = 0.f; }
        u32x4 w; w.x = pk2(v[0], v[1]); w.y = pk2(v[2], v[3]); w.z = pk2(v[4], v[5]); w.w = pk2(v[6], v[7]);
        *(u32x4*)(X.EtT + (size_t)row * CHGH + k0) = w; }
}
__device__ __forceinline__ void p1_router_fold(const Ctx& X) {
    const int gt = X.vcu * NTHR + (X.wave * 64 + lane_now()), NGT = X.G * NTHR; const int gw = X.vcu * NWAVES + X.wave, NGW = X.G * NWAVES;
    for (int i = gt; i < NB * 128 * (D / 8); i += NGT) { const int k0 = (i & 127) * 8, n = (i >> 7) & 127, b = i >> 14; u32x4 w = {0u, 0u, 0u, 0u};
        if (n < 36) { const float* md = X.mod + (size_t)b * NMOD + 4 * D + k0; float v[8];
#pragma unroll
            for (int j = 0; j < 8; ++j) { const int k = k0 + j; const float wr = (n < 4) ? X.rc_w[k * 4 + n] : X.rf_w[k * 32 + (n - 4)]; v[j] = X.g2[k] * (1.0f + md[j]) * wr; }
            w.x = pk2(v[0], v[1]); w.y = pk2(v[2], v[3]); w.z = pk2(v[4], v[5]); w.w = pk2(v[6], v[7]); }
        *(u32x4*)(X.WrB + ((size_t)(b * 128 + n) * D + k0)) = w; }
    for (int it = gw; it < NB * 36; it += NGW) { const int b = it / 36, n = it % 36; const float* sh = X.mod + (size_t)b * NMOD + 3 * D; float sm = 0.f;
#pragma unroll
        for (int j = 0; j < 16; ++j) { const int k = lane_now() + 64 * j; sm += sh[k] * ((n < 4) ? X.rc_w[k * 4 + n] : X.rf_w[k * 32 + (n - 4)]); }
        sm = wave_sum(sm);
        if (lane_now() == 0) X.cbias[b * 64 + n] = sm + ((n < 4) ? X.rc_b[n] : X.rf_b[n - 4]); }
}
__device__ __forceinline__ void p1_inproj(const Ctx& X) {
    for (int tile = X.vcu; tile < T / 256; tile += X.G) {
        p1_rows(X, tile);
        WG_SYNC();
        run_gemm<FAST_P1, false>(X, D, D, SchedTileN{(const char*)(X.u + (size_t)tile * 256 * D), (const char*)X.WinT, (size_t)256 * D * 2, 3, D / 64, (size_t)128 * D * 2}, EpiInProj{X.UX, X.upool, X.b_in, tile});
    }
    p1_tables(X);
    p1_router_fold(X);
}

struct NoCol {};
struct EpiSsum { float* S;
    static constexpr int MB = 4; static constexpr bool PAIR = false;
    typedef NoPre Pre; typedef NoCol Col;
    __device__ __forceinline__ Col col(const Unit&, int) const { return Col{}; }
    __device__ __forceinline__ Pre pre(const Unit&, int, int) const { return Pre{}; }
    __device__ __forceinline__ void operator()(const Unit&, int r, int c, f32x4 v0, f32x4 v1, const Pre&, const Col&) const { if (c < 128) { *(f32x4*)(S + r * 128 + c) = v0; *(f32x4*)(S + r * 128 + c + 4) = v1; } } };
struct EpiS5Y { const bf16* UXg; bf16* YZM; const float* dskip; int g, pm;
    static constexpr int MB = 4; static constexpr bool PAIR = false;
    struct Pre { u32x4 uw; }; struct Col { f32x4 d0, d1; };
    __device__ __forceinline__ Col col(const Unit&, int c) const { const int h0 = c & 15; return Col{*(const f32x4*)(dskip + g * GH + h0), *(const f32x4*)(dskip + g * GH + h0 + 4)}; }
    __device__ __forceinline__ Pre pre(const Unit&, int r, int c) const { const int j = c >> 4, h0 = c & 15, ci = 256 * pm + r;
        return Pre{*(const u32x4*)(UXg + (size_t)ci * KX + 128 + j * 16 + h0)}; }
    __device__ __forceinline__ void operator()(const Unit&, int r, int c, f32x4 v0, f32x4 v1, const Pre& p, const Col& k) const {
        const int j = c >> 4, h0 = c & 15, ci = 256 * pm + r;
        f32x4 u0, u1; unpack8(p.uw, u0, u1);
        v0 += k.d0 * u0; v1 += k.d1 * u1;
#pragma unroll
        for (int i = 0; i < 4; ++i) { v0[i] = gelu_tanh(v0[i]); v1[i] = gelu_tanh(v1[i]); }
        *(u32x4*)(YZM + ((size_t)ci * CH + j) * D + g * GH + h0) = pack8(v0, v1);
    } };
__device__ __forceinline__ void p2_s5(const Ctx& X) {
    for (int id = X.vcu; id < NG * (NCOL / 256); id += X.G) { const int g = id / (NCOL / 256), pm = id % (NCOL / 256);
        bf16* UXg = X.UX + (size_t)g * NCOL * KX; const bf16* Arow = UXg + (size_t)(256 * pm) * KX;
        float* S = X.ssum + (size_t)X.vcu * 256 * 128;
        run_gemm<FAST_P2, false>(X, KX, CHGH, SchedTileN{(const char*)(Arow + 128), (const char*)(X.EtT + (size_t)g * 256 * CHGH), 0, 1, CHGH / 64, (size_t)128 * CHGH * 2}, EpiSsum{S});
        WG_SYNC();
        if (X.wave < 256 / NCHB) { const int bb = X.wave, p = lane_now(); const f32x2 L = X.lpow[((size_t)g * 65 + CH) * NP + p]; float sr = 0.f, si = 0.f;
            for (int c0 = 0; c0 < NCHB; c0 += 32) { float ar[32], ai[32];
#pragma unroll
                for (int c = 0; c < 32; ++c) { const int r = bb * NCHB + c0 + c; ar[c] = S[r * 128 + p]; ai[c] = S[r * 128 + 64 + p]; }
#pragma unroll
                for (int c = 0; c < 32; ++c) { const int r = bb * NCHB + c0 + c; bf16* row = UXg + (size_t)(256 * pm + r) * KX; row[p] = (bf16)f2bf(sr); row[64 + p] = (bf16)f2bf(si);
                    const float nr = L.x * sr - L.y * si + ar[c]; si = L.x * si + L.y * sr + ai[c]; sr = nr; } } }
        WG_SYNC();
        run_gemm<FAST_P2, false>(X, KX, KX, SchedTileN{(const char*)Arow, (const char*)(X.TG + (size_t)g * CHGH * KX), 0, 1, KX / 64, (size_t)128 * KX * 2}, EpiS5Y{UXg, X.YZM, X.ssm_d, g, pm});
        WG_SYNC();
    }
}

struct SchedP3y { const char* yzm; const char* wglu; const char* pssm; const char* weff; int q;
    __device__ __forceinline__ bool next(int i, Unit& un) const { const int k = i + (q != 0); if (k >= 3) return false;
        if (k == 0) { un.A = yzm; un.B = wglu; un.nt = 4; un.i0 = 0; } else if (k == 1) { un.A = yzm + 512 * 2; un.B = weff + (size_t)(256 * q) * D * 2; un.nt = 8; un.i0 = 1; } else { un.A = yzm + 256 * 2; un.B = pssm + (size_t)(256 * q) * D * 2; un.nt = 4; un.i0 = 5; }
        un.B1 = un.B + (size_t)128 * D * 2; un.i1 = 0; un.i2 = 0; un.i3 = 0; return true; }
    __device__ __forceinline__ unsigned row_off(const Unit&, int) const { return 0u; } };
__device__ __forceinline__ size_t lin_elem(int r, int c, int bj) { const int ai = r >> 7, wr = (r >> 6) & 1, m = (r >> 4) & 3, fr = r & 15, wc = (c >> 5) & 3, fq = (c >> 3) & 3;
    return (size_t)((((ai * 4 + m) * 2 + bj) * 512 + (wr * 4 + wc) * 64 + fq * 16 + fr) * 8); }
struct EpiP3y { bf16* YZM; bf16* T1; bf16* T2; const float* b_glu; int tile;
    static constexpr int MB = 4; static constexpr bool PAIR = false;
    struct Pre { u32x4 y; }; struct Col { f32x4 b0, b1; };
    __device__ __forceinline__ Col col(const Unit& u, int c) const { Col k; if (u.i0 == 0) { k.b0 = *(const f32x4*)(b_glu + c); k.b1 = *(const f32x4*)(b_glu + c + 4); } else { k.b0 = (f32x4){0.f, 0.f, 0.f, 0.f}; k.b1 = k.b0; } return k; }
    __device__ __forceinline__ Pre pre(const Unit& u, int r, int c) const { Pre p;
        if (u.i0 == 0) p.y = *(const u32x4*)(YZM + (size_t)(tile * 256 + r) * D + c); else p.y = (u32x4){0u, 0u, 0u, 0u};
        return p; }
    __device__ __forceinline__ void operator()(const Unit& u, int r, int c, f32x4 v0, f32x4 v1, const Pre& p, const Col& k) const { const size_t ro = (size_t)(tile * 256 + r) * D;
        if (u.i0 == 0) { f32x4 y0, y1; unpack8(p.y, y0, y1); *(u32x4*)(YZM + ro + 256 + c) = pack8(y0 * sig4(v0 + k.b0), y1 * sig4(v1 + k.b1)); }
        else { const int q = u.i0 - 1; bf16* O = (q < 4) ? T2 : T1; *(u32x4*)(O + (size_t)(q & 3) * 65536 + lin_elem(r, c & 127, c >> 7)) = pack8(v0, v1); } } };
struct SchedP3g { const char* u; const char* win; int q;
    __device__ __forceinline__ bool next(int i, Unit& un) const { if (i >= 2) return false; const int cb = 2 * q + i;
        un.A = u; un.B = win + (size_t)(128 * cb) * D; un.B1 = win + (size_t)(1024 + 128 * cb) * D; un.nt = 8; un.i0 = cb;   un.i1 = 0; un.i2 = 0; un.i3 = 0; return true; }
    __device__ __forceinline__ unsigned row_off(const Unit&, int) const { return 0u; } };
struct EpiP3g { bf16* P; const bf16* T1; const bf16* T2; const float* b_in; int tile;
    static constexpr int MB = 4; static constexpr bool PAIR = true;
    struct Pre { u32x4 t1, t2; }; struct Col { f32x4 a0, a1, b0, b1; };
    __device__ __forceinline__ Col col(const Unit& u, int c) const { const int cc = 128 * u.i0 + c; return Col{*(const f32x4*)(b_in + 768 + cc), *(const f32x4*)(b_in + 768 + cc + 4), *(const f32x4*)(b_in + 1792 + cc), *(const f32x4*)(b_in + 1792 + cc + 4)}; }
    __device__ __forceinline__ Pre pre(const Unit& u, int r, int c) const { const size_t o = lin_elem(r, c, u.i0 & 1); return Pre{*(const u32x4*)(T1 + o), *(const u32x4*)(T2 + o)}; }
    __device__ __forceinline__ void pair(const Unit& u, int r, int c, f32x4 g0, f32x4 g1, f32x4 h0, f32x4 h1, const Pre& p, const Col& k) const { const size_t o = (size_t)(tile * 256 + r) * D + 128 * u.i0 + c;
        f32x4 x0, x1, y0, y1; unpack8(p.t1, x0, x1); unpack8(p.t2, y0, y1);
        constexpr float inv = 1.0f / (W8_SCALE * A8_SCALE);
        *(u32x4*)(P + o) = pack8(sig4(g0 * inv + k.a0) * x0 + sig4(h0 * inv + k.b0) * y0, sig4(g1 * inv + k.a1) * x1 + sig4(h1 * inv + k.b1) * y1); } };
struct EpiWout { const float* x; const float* gate; bf16* h1; int tile;
    static constexpr int MB = 4; static constexpr bool PAIR = false;
    struct Pre { f32x4 x0, x1; }; struct Col { f32x4 g0, g1; };
    __device__ __forceinline__ Col col(const Unit& u, int c) const { const int cc = 256 * u.i0 + c; return Col{*(const f32x4*)(gate + cc), *(const f32x4*)(gate + cc + 4)}; }
    __device__ __forceinline__ Pre pre(const Unit& u, int r, int c) const { const size_t o = (size_t)(tile * 256 + r) * D + 256 * u.i0 + c; return Pre{*(const f32x4*)(x + o), *(const f32x4*)(x + o + 4)}; }
    __device__ __forceinline__ void operator()(const Unit& u, int r, int c, f32x4 v0, f32x4 v1, const Pre& p, const Col& k) const { const size_t o = (size_t)(tile * 256 + r) * D + 256 * u.i0 + c;
        const f32x4 h0 = p.x0 + k.g0 * v0, h1v = p.x1 + k.g1 * v1;
        *(u32x4*)(h1 + o) = pack8(h0, h1v); } };
struct EpiRouter { float* logits; const float* cb; const LAS float* rstd; int tile;
    static constexpr int MB = 4; static constexpr bool PAIR = false;
    typedef NoPre Pre; typedef NoCol Col;
    __device__ __forceinline__ Col col(const Unit&, int) const { return Col{}; }
    __device__ __forceinline__ Pre pre(const Unit&, int, int) const { return Pre{}; }
    __device__ __forceinline__ void operator()(const Unit&, int r, int c, f32x4 v0, f32x4 v1, const Pre&, const Col&) const { if (c < 40) { float* o = logits + (size_t)(tile * 256 + r) * 64 + c; const float rs = rstd[r];
#pragma unroll
            for (int i = 0; i < 8; ++i) { const int n = c + i; const float bias = (n < 36) ? cb[n] : 0.f; o[i] = (i < 4 ? v0[i & 3] : v1[i & 3]) * rs + bias; } } } };

__device__ __forceinline__ void moe_weights_convert(const Ctx& X) {
    const int gw = X.vcu * NWAVES + X.wave, NGW = X.G * NWAVES;
    LAS float* scr = (LAS float*)(X.lds + X.wave * 16640);
    constexpr int I_G = NE * (D / 64) * (DE / 64), I_D = NE * (DE / 64) * (D / 64);
    for (int it = gw; it < 2 * I_G + I_D; it += NGW) { int r = it;
        if (r < 2 * I_G) { const int up = r >= I_G; if (up) r -= I_G; const int per = (D / 64) * (DE / 64), e = r / per, q = r % per, nb = DE / 64;
            transpose_item_f8((up ? X.moe_u : X.moe_g) + (size_t)e * D * DE, DE, (unsigned char*)X.W1T + (size_t)e * D * D, D, scr, 64 * (q / nb), 64 * (q % nb), lane_now(), NGateUp{up}); continue; } r -= 2 * I_G;
        { const int per = (DE / 64) * (D / 64), e = r / per, q = r % per, nb = D / 64;
            transpose_item_f8(X.moe_d + (size_t)e * DE * D, D, (unsigned char*)X.WdT + (size_t)e * D * DE, DE, scr, 64 * (q / nb), 64 * (q % nb), lane_now(), NId{}); } }
    WG_SYNC();
}
__device__ __forceinline__ void p3_mixer(const Ctx& X, const bool do_route = true) {
    LAS float* rstd_l = (LAS float*)(X.lds + LDS_CTL_OFF + LC_ROWSQ); LAS unsigned* hist = (LAS unsigned*)(X.lds + LDS_CTL_OFF + LC_HIST); LAS unsigned* base = (LAS unsigned*)(X.lds + LDS_CTL_OFF + LC_BASE);
    for (int tile = X.vcu; tile < T / 256; tile += X.G) {
        const int b = tile >> 3, t0 = (tile & 7) * 256; const float* md = X.mod + (size_t)b * NMOD; const size_t tok0 = (size_t)tile * 256;
        if ((X.wave * 64 + lane_now()) < 32) hist[(X.wave * 64 + lane_now())] = 0u;
        { int tq = (X.wave * 64 + lane_now()); asm volatile("" : "+v"(tq)); const int cg = tq & 63, rb = tq >> 6, w = 2 << (cg >> 4), r0 = 32 * rb; const bf16* pb = X.upool + tok0 * DPOOL + 8 * cg; bf16* ob = X.YZM + tok0 * D + 512 + 8 * cg;
            f32x4 S0 = {0.f, 0.f, 0.f, 0.f}, S1 = S0;
            { u32x4 pv[15];
#pragma unroll
                for (int i = 1; i < 16; ++i) pv[i - 1] = *(const u32x4*)(pb + (ptrdiff_t)(r0 - i) * DPOOL);
#pragma unroll
                for (int i = 1; i < 16; ++i) { f32x4 a, bq; unpack8(pv[i - 1], a, bq); const float ok = (i < w && t0 + r0 - i >= 0) ? 1.f : 0.f; S0 += a * ok; S1 += bq * ok; } }
            for (int rr8 = 0; rr8 < 32; rr8 += 8) { u32x4 cu[8], ol[8];
#pragma unroll
                for (int k = 0; k < 8; ++k) { const int r = r0 + rr8 + k; cu[k] = *(const u32x4*)(pb + (ptrdiff_t)r * DPOOL); ol[k] = *(const u32x4*)(pb + (ptrdiff_t)(r - w + 1) * DPOOL); }
#pragma unroll
                for (int k = 0; k < 8; ++k) { const int r = r0 + rr8 + k, t = t0 + r; f32x4 c0, c1, o0, o1; unpack8(cu[k], c0, c1); unpack8(ol[k], o0, o1);
                    S0 += c0; S1 += c1; const float inv = 1.0f / (float)((t + 1 < w) ? t + 1 : w);
                    *(u32x4*)(ob + (size_t)r * D) = pack8(S0 * inv - c0, S1 * inv - c1);
                    const float ok = (t - w + 1 >= 0) ? 1.f : 0.f; S0 -= o0 * ok; S1 -= o1 * ok; } } }
        WG_SYNC();
        const bool conv = do_route && tile == X.vcu; const int cq = X.vcu & 3;
        if (conv && cq < 2) moe_weights_convert(X);
        {
            const SchedTileN sW{(const char*)(X.P + tok0 * D), (const char*)X.WoutT, (size_t)256 * D * 2, 4, D / 64, (size_t)128 * D * 2};
#pragma unroll 1
            for (int q = 0; q < 4; ++q) {
                const SchedP3y sY{(const char*)(X.YZM + tok0 * D), (const char*)X.WgluT, (const char*)X.PssmT, (const char*)X.WeffT, q};
                const SchedP3g sG{(const char*)(X.u8 + tok0 * D), (const char*)X.Wg8, q};
                Unit fG; sG.next(0, fG);
                run_gemm<FAST_P3, false>(X, D, D, sY, EpiP3y{X.YZM, X.h1 + tok0 * D, X.Q + tok0 * D, X.b_glu, tile}, q > 0, true, &fG, D / 2, D / 2);
                WG_SYNC();
                Unit fN; if (q < 3) { const SchedP3y sY1{sY.yzm, sY.wglu, sY.pssm, sY.weff, q + 1}; sY1.next(0, fN); } else sW.next(0, fN);
                run_gemm<FAST_P3, false, EpiP3g, SchedP3g, true>(X, D / 2, D / 2, sG, EpiP3g{X.P, X.h1 + tok0 * D, X.Q + tok0 * D, X.b_in, tile}, true, true, &fN, D, D);
                WG_SYNC();
            }
            run_gemm<FAST_P3, false>(X, D, D, sW, EpiWout{X.x, md + 2 * D, X.h1, tile}, true);
            WG_SYNC();
        }
        if (conv && cq >= 2) moe_weights_convert(X);
        { int ln = lane_now(); asm volatile("" : "+v"(ln)); f32x4 sc[4], sh[4];
#pragma unroll
            for (int j = 0; j < 2; ++j)
#pragma unroll
                for (int hlf = 0; hlf < 2; ++hlf) { const int c0 = 8 * ln + 512 * j + 4 * hlf; sc[2 * j + hlf] = *(const f32x4*)(X.g2 + c0) * (*(const f32x4*)(md + 4 * D + c0) + 1.0f); sh[2 * j + hlf] = *(const f32x4*)(md + 3 * D + c0); }
            for (int r4 = X.wave; r4 < 256; r4 += 4 * NWAVES) { u32x4 hv[4][2];
#pragma unroll
                for (int k = 0; k < 4; ++k)
#pragma unroll
                    for (int j = 0; j < 2; ++j) hv[k][j] = *(const u32x4*)(X.h1 + (tok0 + r4 + 8 * k) * D + 8 * ln + 512 * j);
#pragma unroll
                for (int k = 0; k < 4; ++k) { const int r = r4 + 8 * k; float ss = 0.f;
#pragma unroll
                    for (int j = 0; j < 2; ++j) { f32x4 a, bq; unpack8(hv[k][j], a, bq); ss += (a.x * a.x + a.y * a.y) + (a.z * a.z + a.w * a.w) + (bq.x * bq.x + bq.y * bq.y) + (bq.z * bq.z + bq.w * bq.w); }
                    const float rstd = 1.0f / sqrtf(wave_sum(ss) * (1.0f / D) + EPS); if (ln == 0) rstd_l[r] = rstd;
#pragma unroll
                    for (int j = 0; j < 2; ++j) { f32x4 a, bq; unpack8(hv[k][j], a, bq); const f32x4 ya = a * rstd * sc[2 * j] + sh[2 * j], yb = bq * rstd * sc[2 * j + 1] + sh[2 * j + 1];
                        u32x2 w8; w8.x = pk4f8(ya * A8_SCALE); w8.y = pk4f8(yb * A8_SCALE); *(u32x2*)(X.u2f8 + (tok0 + r) * D + 8 * ln + 512 * j) = w8; } } } }
        WG_SYNC();
        run_gemm<FAST_P3, false>(X, D, D, SchedTileN{(const char*)(X.h1 + tok0 * D), (const char*)(X.WrB + (size_t)b * 128 * D), 0, 1, D / 64, 0}, EpiRouter{X.logits, X.cbias + b * 64, rstd_l, tile});
        WG_SYNC();
        if (!do_route) continue;
        int tr = (X.wave * 64 + lane_now()); asm volatile("" : "+v"(tr));
        int e0 = 0, e1 = 0; float w0 = 0.f, w1 = 0.f; unsigned rk0 = 0, rk1 = 0;
        if (tr < 256) { const float* lg = X.logits + (tok0 + tr) * 64;
            int grp = 0; float lm = lg[0];
#pragma unroll
            for (int j = 1; j < 4; ++j) { const float v = lg[j]; if (v > lm) { lm = v; grp = j; } }
            float se = 0.f;
#pragma unroll
            for (int j = 0; j < 4; ++j) se += __expf(lg[j] - lm);
            const float pg = 1.0f / se; const float* lf = lg + 4 + grp * 8;
            int i1 = 0; float l1 = lf[0];
#pragma unroll
            for (int j = 1; j < 8; ++j) { const float v = lf[j]; if (v > l1) { l1 = v; i1 = j; } }
            int i2 = -1; float l2 = -3.0e38f;
#pragma unroll
            for (int j = 0; j < 8; ++j) { const float v = lf[j]; if (j != i1 && v > l2) { l2 = v; i2 = j; } }
            const float ex = __expf(l2 - l1); w0 = pg / (1.0f + ex); w1 = pg * ex / (1.0f + ex); e0 = grp * 8 + i1; e1 = grp * 8 + i2;
            rk0 = atomicAdd((unsigned*)(hist + e0), 1u); rk1 = atomicAdd((unsigned*)(hist + e1), 1u); }
        __syncthreads();
        if (tr < 32) base[tr] = atomicAdd(X.ctl + CW_GCNT + tr, (unsigned)hist[tr]);
        __syncthreads();
        if (tr < 256) { const int tok = (int)tok0 + tr; const unsigned p0 = base[e0] + rk0, p1 = base[e1] + rk1;
            X.sorted[(size_t)e0 * CAP + p0] = tok; X.sorted[(size_t)e1 * CAP + p1] = tok;
            *(i32x4*)(X.tokslot + 4 * tok) = (i32x4){(e0 << 16) | (int)p0, (e1 << 16) | (int)p1, __builtin_bit_cast(int, w0), __builtin_bit_cast(int, w1)}; }
        __syncthreads();
    }
}

__device__ __forceinline__ void moe_table(const Ctx& X) {
    LAS unsigned* tp = (LAS unsigned*)(X.lds + LDS_CTL_OFF + LC_TPFX); LAS unsigned* cnt = (LAS unsigned*)(X.lds + LDS_CTL_OFF + LC_CNT); LAS unsigned* ul = (LAS unsigned*)(X.lds + LDS_CTL_OFF + LC_ULIST);
    const int tid = X.wave * 64 + lane_now();
    __syncthreads();
    if (tid < 32) cnt[tid] = __hip_atomic_load(X.ctl + CW_GCNT + tid, __ATOMIC_RELAXED, __HIP_MEMORY_SCOPE_AGENT);
    __syncthreads();
    if (tid == 0) { unsigned s = 0; for (int e = 0; e < NE; ++e) { tp[e] = s; s += (cnt[e] + 255u) >> 8; } tp[NE] = s; }
    __syncthreads();
    if (tid < 63) { const unsigned NU = tp[NE] * 4u, uu = (unsigned)X.vcu + (unsigned)tid * (unsigned)X.G;
        if (uu < NU) { const unsigned mt = uu >> 2, pn = uu & 3; int e = 0; for (int k = 1; k < NE; ++k) if (tp[k] <= mt) e = k; ul[1 + tid] = mt | (pn << 10) | ((unsigned)e << 12) | ((mt - tp[e]) << 17); }
        if (tid == 0) { const unsigned n = (NU > (unsigned)X.vcu) ? (NU - (unsigned)X.vcu + (unsigned)X.G - 1u) / (unsigned)X.G : 0u; ul[0] = n < 63u ? n : 63u; } }
    __syncthreads();
}
__device__ __forceinline__ int find_expert(const LAS unsigned* tp, unsigned mt) { int e = 0;
#pragma unroll 1
    for (int k = 1; k < NE; ++k) if (tp[k] <= mt) e = k;
    return e; }
struct SchedMoe { const LAS unsigned* ul; const LAS unsigned* cnt; const int* sorted; const char* Abase; size_t a_tile; const char* Bbase; size_t b_exp, b_pn, b_half; int nt;
    __device__ __forceinline__ bool next(int i, Unit& u) const { if (i >= (int)__builtin_amdgcn_readfirstlane((int)ul[0])) return false;
        const unsigned w = (unsigned)__builtin_amdgcn_readfirstlane((int)ul[1 + i]); const unsigned mt = w & 1023u; const int pn = (w >> 10) & 3, eu = (w >> 12) & 31, lt = (int)(w >> 17);
        u.A = Abase + (size_t)mt * a_tile; u.B = Bbase + (size_t)eu * b_exp + (size_t)pn * b_pn; u.B1 = u.B + b_half; u.nt = nt; u.i0 = (int)mt; u.i1 = pn; u.i2 = eu; u.i3 = lt; return true; }
    __device__ __forceinline__ unsigned row_off(const Unit& u, int row) const { const int pos = 256 * u.i3 + row; const int tok = (pos < (int)cnt[u.i2]) ? sorted[(size_t)u.i2 * CAP + pos] : 0; return (unsigned)tok * (unsigned)D; } };
struct EpiAct { unsigned char* act;
    static constexpr int MB = 4; static constexpr bool PAIR = true;
    typedef NoPre Pre; typedef NoCol Col;
    __device__ __forceinline__ Col col(const Unit&, int) const { return Col{}; }
    __device__ __forceinline__ Pre pre(const Unit&, int, int) const { return Pre{}; }
    __device__ __forceinline__ void pair(const Unit& u, int r, int c, f32x4 g0, f32x4 g1, f32x4 u0, f32x4 u1, const Pre&, const Col&) const {
        constexpr float inv = 1.0f / (W8_SCALE * A8_SCALE);
#pragma unroll
        for (int i = 0; i < 4; ++i) { const float a = g0[i] * inv, b = g1[i] * inv; g0[i] = a * sigmoidf_(a) * (u0[i] * inv) * A8_SCALE; g1[i] = b * sigmoidf_(b) * (u1[i] * inv) * A8_SCALE; }
        u32x2 w; w.x = pk4f8(g0); w.y = pk4f8(g1); *(u32x2*)(act + ((size_t)u.i0 * 256 + r) * DE + 128 * u.i1 + c) = w; } };
struct EpiDown { unsigned char* ys;
    static constexpr int MB = 4; static constexpr bool PAIR = false;
    typedef NoPre Pre; typedef NoCol Col;
    __device__ __forceinline__ Col col(const Unit&, int) const { return Col{}; }
    __device__ __forceinline__ Pre pre(const Unit&, int, int) const { return Pre{}; }
    __device__ __forceinline__ void operator()(const Unit& u, int r, int c, f32x4 v0, f32x4 v1, const Pre&, const Col&) const { constexpr float sc = Y8_SCALE / (W8_SCALE * A8_SCALE);
        u32x2 w; w.x = pk4f8(v0 * sc); w.y = pk4f8(v1 * sc); *(u32x2*)(ys + ((size_t)u.i0 * 256 + r) * D + 256 * u.i1 + c) = w; } };
__device__ __forceinline__ void p4_moe_up(const Ctx& X) {
    moe_table(X); const LAS unsigned* ul = (const LAS unsigned*)(X.lds + LDS_CTL_OFF + LC_ULIST); const LAS unsigned* cnt = (const LAS unsigned*)(X.lds + LDS_CTL_OFF + LC_CNT);
    run_gemm<FAST_P4, true, EpiAct, SchedMoe, true>(X, D / 2, D / 2, SchedMoe{ul, cnt, X.sorted, (const char*)X.u2f8, 0, (const char*)X.W1T, (size_t)D * D, (size_t)128 * D, (size_t)DE * D, D / 128}, EpiAct{(unsigned char*)X.act});
}
__device__ __forceinline__ void p5_moe_down(const Ctx& X) {
    moe_table(X); const LAS unsigned* ul = (const LAS unsigned*)(X.lds + LDS_CTL_OFF + LC_ULIST); const LAS unsigned* cnt = (const LAS unsigned*)(X.lds + LDS_CTL_OFF + LC_CNT);
    run_gemm<FAST_P5, false, EpiDown, SchedMoe, true>(X, DE / 2, DE / 2, SchedMoe{ul, cnt, X.sorted, (const char*)X.act, (size_t)256 * DE, (const char*)X.WdT, (size_t)D * DE, (size_t)256 * DE, (size_t)128 * DE, DE / 128}, EpiDown{(unsigned char*)X.ys});
}
__device__ __forceinline__ void p6_final(const Ctx& X) {
    moe_table(X); LAS unsigned* tp = (LAS unsigned*)(X.lds + LDS_CTL_OFF + LC_TPFX);
    const int gw = X.vcu * NWAVES + X.wave, NGW = X.G * NWAVES;
    int tsx = 0, tsy = 0, tsz = 0, tsw = 0;
    { const int tokl = gw + lane_now() * NGW; if (tokl < T) { const int* tq = X.tokslot + 4 * tokl; tsx = tq[0]; tsy = tq[1]; tsz = tq[2]; tsw = tq[3]; } }
    int jt = 0;
    for (int tk4 = gw; tk4 < T; tk4 += 4 * NGW, jt += 4) {
        int s0[4], s1[4]; float w0[4], w1[4];
#pragma unroll
        for (int k = 0; k < 4; ++k) { s0[k] = __builtin_amdgcn_readlane(tsx, jt + k); s1[k] = __builtin_amdgcn_readlane(tsy, jt + k);
            w0[k] = __builtin_bit_cast(float, __builtin_amdgcn_readlane(tsz, jt + k)) * (1.0f / Y8_SCALE); w1[k] = __builtin_bit_cast(float, __builtin_amdgcn_readlane(tsw, jt + k)) * (1.0f / Y8_SCALE); }
        u32x4 hv[4][2]; u32x2 av[4][2], bv[4][2]; const unsigned char* ys8 = (const unsigned char*)X.ys;
#pragma unroll
        for (int k = 0; k < 4; ++k) { const int tok = tk4 + k * NGW; const size_t r0 = (size_t)tp[s0[k] >> 16] * 256 + (s0[k] & 0xffff), r1 = (size_t)tp[s1[k] >> 16] * 256 + (s1[k] & 0xffff);
#pragma unroll
            for (int j = 0; j < 2; ++j) { const int c0 = 8 * lane_now() + 512 * j; hv[k][j] = *(const u32x4*)(X.h1 + (size_t)tok * D + c0); av[k][j] = *(const u32x2*)(ys8 + r0 * D + c0); bv[k][j] = *(const u32x2*)(ys8 + r1 * D + c0); } }
#pragma unroll
        for (int k = 0; k < 4; ++k) { const int tok = tk4 + k * NGW, b = tok >> 11; const float* g2 = X.mod + (size_t)b * NMOD + 5 * D;
            f32x4 v[4]; float s = 0.f;
#pragma unroll
            for (int j = 0; j < 2; ++j) { const int c0 = 8 * lane_now() + 512 * j; f32x4 h0, h1v, a0, a1, b0, b1;
                unpack8(hv[k][j], h0, h1v); unpack8f8(av[k][j], a0, a1); unpack8f8(bv[k][j], b0, b1);
                v[2 * j] = h0 + *(const f32x4*)(g2 + c0) * (a0 * w0[k] + b0 * w1[k]); v[2 * j + 1] = h1v + *(const f32x4*)(g2 + c0 + 4) * (a1 * w0[k] + b1 * w1[k]);
#pragma unroll
                for (int q = 0; q < 2; ++q) { const f32x4 t = v[2 * j + q]; s += (t.x * t.x + t.y * t.y) + (t.z * t.z + t.w * t.w); } }
            const float rstd = 1.0f / sqrtf(wave_sum(s) * (1.0f / D) + EPS);
#pragma unroll
            for (int j = 0; j < 2; ++j)
#pragma unroll
                for (int q = 0; q < 2; ++q) { const int c0 = 8 * lane_now() + 512 * j + 4 * q; *(f32x4*)(X.out + (size_t)tok * D + c0) = v[2 * j + q] * rstd * *(const f32x4*)(X.gf + c0); } }
    }
}

struct Args { const float* in[31]; float* out; unsigned char* ws; int ph_lo, ph_hi; };
typedef const Args __attribute__((address_space(4)))* KArgs;
__device__ __forceinline__ Ctx make_ctx(LAS unsigned char* lds, int wave, int vcu, int G) {
    KArgs a = (KArgs)__builtin_amdgcn_kernarg_segment_ptr(); asm volatile("" : "+s"(a));
    Ctx X; X.lds = lds; X.wave = wave; X.vcu = vcu; X.G = G;
    X.x = a->in[0]; X.c = a->in[1]; X.w_mod = a->in[2]; X.b_mod = a->in[3]; X.g1 = a->in[4]; X.w_in = a->in[5]; X.b_in = a->in[6]; X.lam_re = a->in[7]; X.lam_im = a->in[8]; X.log_dt = a->in[9];
    X.b_re = a->in[10]; X.b_im = a->in[11]; X.c_re = a->in[12]; X.c_im = a->in[13]; X.ssm_d = a->in[14]; X.w_glu = a->in[15]; X.b_glu = a->in[16]; X.pool_w = a->in[17]; X.pool_scale = a->in[18];
    X.p_ssm = a->in[19]; X.p_pool = a->in[20]; X.w_out = a->in[21]; X.g2 = a->in[22]; X.rc_w = a->in[23]; X.rc_b = a->in[24]; X.rf_w = a->in[25]; X.rf_b = a->in[26];
    X.moe_g = a->in[27]; X.moe_u = a->in[28]; X.moe_d = a->in[29]; X.gf = a->in[30];
    float* out = a->out; unsigned char* ws = a->ws; X.out = out; X.ws = ws;
    X.ctl = (unsigned*)(ws + WS_CTL); X.mod = (float*)(ws + WS_MOD); X.lpow = (f32x2*)(ws + WS_LPOW); X.bbar = (f32x2*)(ws + WS_BBAR); X.ktab = (float*)(ws + WS_KTAB);
    X.tokslot = (int*)(ws + WS_TOKSLOT); X.sorted = (int*)(ws + WS_SORTED); X.slotw = (float*)(ws + WS_SLOTW); X.logits = (float*)(ws + WS_LOGITS);
    X.WinT = (bf16*)(ws + WS_WIN); X.WgluT = (bf16*)(ws + WS_WGLU); X.PssmT = (bf16*)(ws + WS_PSSM); X.WeffT = (bf16*)(ws + WS_WEFF); X.WoutT = (bf16*)(ws + WS_WOUT); X.WrB = (bf16*)(ws + WS_SLOTW); X.cbias = (float*)(ws + WS_KTAB + 512 * 1024);
    X.W1T = (bf16*)(ws + WS_W1); X.WdT = (bf16*)(ws + WS_WD); X.TG = (bf16*)(ws + WS_TG); X.EtT = (bf16*)(ws + WS_ET); X.ssum = (float*)(ws + WS_SSUM);
    X.h1 = (bf16*)(ws + WS_H1); X.u2 = (bf16*)(ws + WS_U2); X.u = (bf16*)(ws + WS_U); X.UX = (bf16*)(ws + WS_UX); X.upool = (bf16*)(ws + WS_UPOOL); X.YZM = (bf16*)(ws + WS_YZM); X.u2f8 = ws + WS_U2F8; X.u8 = ws + WS_U8; X.Wg8 = ws + WS_WG8;
    X.P = (bf16*)out; X.Q = (bf16*)out + (size_t)T * D; X.act = (bf16*)out; X.ys = (bf16*)(ws + WS_YS);
    return X;
}
__global__ void __launch_bounds__(NTHR, 2) mk_fwd(Args a) {
    extern __shared__ __attribute__((aligned(16))) unsigned char lds_raw[];
    LAS unsigned char* lds = (LAS unsigned char*)lds_raw; const int wave = __builtin_amdgcn_readfirstlane((int)threadIdx.x >> 6);
    const int G = gridDim.x; int vcu; { const int bx = blockIdx.x; vcu = (G % 8 == 0) ? (bx % 8) * (G / 8) + bx / 8 : bx; }
    const int lo = a.ph_lo, hi = a.ph_hi;
#define IN(k) (lo <= (k) && (k) < hi)
#define BOTH(k) (IN(k) && IN((k) + 1))
    for (int i = (wave * 64 + lane_now()); i < (LDS_BYTES - LDS_CTL_OFF) / 4; i += NTHR) ((LAS unsigned*)(lds + LDS_CTL_OFF))[i] = 0u;
    __syncthreads();
    unsigned* barw = (unsigned*)(a.ws + WS_CTL) + CW_BAR;
    XcdBarrier bar; bar.bar = barw; bar.x = 0; bar.st = nullptr; bar.wave = wave;
    if (hi - lo > 1) bar = xcd_barrier_post(barw, (volatile LAS unsigned*)(lds + LDS_CTL_OFF + LC_MISC), wave);
    if (IN(0)) { { const Ctx X = make_ctx(lds, wave, vcu, G); p0_prep(X); } if (BOTH(0)) xcd_barrier(bar); }
    if (IN(1)) { { const Ctx X = make_ctx(lds, wave, vcu, G); p1_inproj(X); } if (BOTH(1)) xcd_barrier(bar); }
    if (IN(2)) { { const Ctx X = make_ctx(lds, wave, vcu, G); p2_s5(X); } if (BOTH(2)) xcd_barrier(bar); }
    if (IN(3)) { { const Ctx X = make_ctx(lds, wave, vcu, G); p3_mixer(X, true); } if (BOTH(3)) xcd_barrier(bar); }
    if (IN(4)) { { const Ctx X = make_ctx(lds, wave, vcu, G); p4_moe_up(X); } if (BOTH(4)) xcd_barrier(bar); }
    if (IN(5)) { { const Ctx X = make_ctx(lds, wave, vcu, G); p5_moe_down(X); } if (BOTH(5)) xcd_barrier(bar); }
    if (IN(6)) { const Ctx X = make_ctx(lds, wave, vcu, G); p6_final(X); }
#undef BOTH
#undef IN
}

extern "C" void kernel_launch(void* const* d_in, const int* in_sizes, int n_in, void* d_out, int out_size, void* d_ws, size_t ws_size, hipStream_t stream) {
    static int grid = 0;
    if (grid == 0) {
        if (n_in != 31 || out_size != T * D || ws_size < WS_END) { fprintf(stderr, "kernel_launch: unexpected shapes (n_in %d out %d ws %zu)\n", n_in, out_size, ws_size); grid = -1; return; }
        int dev = 0, cus = 0;
        if (hipGetDevice(&dev) != hipSuccess || hipDeviceGetAttribute(&cus, hipDeviceAttributeMultiprocessorCount, dev) != hipSuccess) { grid = -1; return; }
        if (hipFuncSetAttribute((const void*)mk_fwd, hipFuncAttributeMaxDynamicSharedMemorySize, LDS_BYTES) != hipSuccess) { fprintf(stderr, "kernel_launch: hipFuncSetAttribute failed\n"); grid = -1; return; }
        grid = cus;
    }
    if (grid < 0) return;
    (void)hipMemsetAsync((char*)d_ws + WS_CTL, 0, CTL_ZERO_BYTES, stream);
    Args a{};
    for (int i = 0; i < 31; ++i) a.in[i] = (const float*)d_in[i];
    a.out = (float*)d_out; a.ws = (unsigned char*)d_ws;
    for (int li = 0; li < MK_N_LAUNCHES; ++li) {
        a.ph_lo = (MK_N_LAUNCHES == 7) ? li : 0; a.ph_hi = (MK_N_LAUNCHES == 7) ? li + 1 : 7;
        hipLaunchKernelGGL(mk_fwd, dim3(grid), dim3(NTHR), LDS_BYTES, stream, a);
    }
}
```

```cpp
#include <hip/hip_runtime.h>
#include <cstdio>

#ifndef MK_N_LAUNCHES
#define MK_N_LAUNCHES 1
#endif

#define GAS __attribute__((address_space(1)))
#define LAS __attribute__((address_space(3)))
typedef unsigned short bf16;
typedef short bf16x8 __attribute__((ext_vector_type(8)));
typedef float f32x4 __attribute__((ext_vector_type(4)));
typedef float f32x2 __attribute__((ext_vector_type(2)));
typedef unsigned u32x4 __attribute__((ext_vector_type(4)));
typedef int i32x4 __attribute__((ext_vector_type(4)));
typedef unsigned u32x2 __attribute__((ext_vector_type(2)));
#define LDS_WAIT() asm volatile("s_waitcnt lgkmcnt(0)" ::: "memory")
#define VM_WAIT() asm volatile("s_waitcnt vmcnt(0)" ::: "memory")
#define WG_SYNC() do { asm volatile("s_waitcnt vmcnt(0) lgkmcnt(0)" ::: "memory"); __syncthreads(); } while (0)

constexpr int D = 1024, NB = 32, SEQ = 2048, T = NB * SEQ, DIN = 2816, DSSM = 256, DPOOL = 512;
constexpr int NG = 16, GH = 16, NP = 64, CH = 16  , CHGH = CH * GH  , NCOL = T / CH  , NCHB = SEQ / CH  , KX = 128 + CHGH  ;
constexpr int NE = 32, DE = 512, CAP = 65536, NMOD = 6 * D;
constexpr int YS_ROWS = 2 * T + NE * 256;
constexpr float EPS = 1e-6f;
constexpr int NWAVES = 8, NTHR = 512;

constexpr size_t MiB = 1u << 20;
constexpr size_t WS_CTL = 0, CTL_ZERO_BYTES = 1 * MiB;
constexpr size_t WS_MOD = 1 * MiB, WS_LPOW = 2 * MiB, WS_BBAR = 3 * MiB, WS_KTAB = 4 * MiB, WS_TOKSLOT = 5 * MiB, WS_SORTED = 6 * MiB, WS_SLOTW = 14 * MiB, WS_LOGITS = 22 * MiB;
constexpr size_t WS_WIN = 38 * MiB, WS_WGLU = 44 * MiB, WS_PSSM = 45 * MiB, WS_WEFF = 47 * MiB, WS_WOUT = 49 * MiB, WS_WR = 51 * MiB, WS_W1 = 52 * MiB, WS_WD = 116 * MiB;
constexpr size_t WS_TG = 148 * MiB, WS_ET = 184 * MiB, WS_SSUM = 192 * MiB, WS_H1 = 224 * MiB, WS_U2 = 352 * MiB;
constexpr size_t WS_U = 480 * MiB, WS_UX = 608 * MiB  , WS_UPOOL = 656 * MiB, WS_YZM = 720 * MiB, WS_U2F8 = 848 * MiB  , WS_U8 = 912 * MiB  , WS_WG8 = 976 * MiB  , WS_END = 978 * MiB;
constexpr size_t WS_YS = WS_U;
static_assert(WS_YS + (size_t)YS_ROWS * D * 2 <= WS_U2F8, "ys overlay");
static_assert((size_t)YS_ROWS * DE * 2 <= (size_t)T * D * 4, "act fits d_out");
constexpr int CW_GCNT = 64;
constexpr int CW_BAR = 4096;

constexpr int LDS_RING = 131072, LDS_CTL_OFF = 135168  , LDS_BYTES = 147456;
constexpr int LC_ROWSQ = 0  , LC_HIST = 1024  , LC_BASE = 1152  , LC_TPFX = 1280  , LC_CNT = 1536  , LC_MISC = 1792, LC_ULIST = 2048  ;

__device__ __forceinline__ unsigned f2bf(float f) { unsigned u = __builtin_bit_cast(unsigned, f); return (u + 0x7fffu + ((u >> 16) & 1u)) >> 16; }
typedef __bf16 bf16v2 __attribute__((ext_vector_type(2)));
__device__ __forceinline__ unsigned pk2(float lo, float hi) { const f32x2 v = {lo, hi}; return __builtin_bit_cast(unsigned, __builtin_convertvector(v, bf16v2)); }
__device__ __forceinline__ float bflo(unsigned w) { return __builtin_bit_cast(float, w << 16); }
__device__ __forceinline__ float bfhi(unsigned w) { return __builtin_bit_cast(float, w & 0xffff0000u); }
__device__ __forceinline__ float bf1(bf16 h) { return __builtin_bit_cast(float, ((unsigned)h) << 16); }
__device__ __forceinline__ u32x4 pack8(f32x4 a, f32x4 b) { u32x4 w; w.x = pk2(a[0], a[1]); w.y = pk2(a[2], a[3]); w.z = pk2(b[0], b[1]); w.w = pk2(b[2], b[3]); return w; }
__device__ __forceinline__ void unpack8(u32x4 w, f32x4& a, f32x4& b) { a = (f32x4){bflo(w.x), bfhi(w.x), bflo(w.y), bfhi(w.y)}; b = (f32x4){bflo(w.z), bfhi(w.z), bflo(w.w), bfhi(w.w)}; }
constexpr float W8_SCALE = 16.f, A8_SCALE = 4.f, Y8_SCALE = 16.f;
__device__ __forceinline__ unsigned pk4f8(f32x4 v) { int r = __builtin_amdgcn_cvt_pk_fp8_f32(v[0], v[1], 0, false); r = __builtin_amdgcn_cvt_pk_fp8_f32(v[2], v[3], r, true); return (unsigned)r; }
__device__ __forceinline__ void unpack8f8(u32x2 w, f32x4& a, f32x4& b) { const f32x2 a0 = __builtin_amdgcn_cvt_pk_f32_fp8((int)w.x, false), a1 = __builtin_amdgcn_cvt_pk_f32_fp8((int)w.x, true), b0 = __builtin_amdgcn_cvt_pk_f32_fp8((int)w.y, false), b1 = __builtin_amdgcn_cvt_pk_f32_fp8((int)w.y, true);
    a = (f32x4){a0[0], a0[1], a1[0], a1[1]}; b = (f32x4){b0[0], b0[1], b1[0], b1[1]}; }
__device__ __forceinline__ float sigmoidf_(float x) { return __builtin_amdgcn_rcpf(1.0f + __expf(-x)); }
__device__ __forceinline__ f32x4 sig4(f32x4 v) { return (f32x4){sigmoidf_(v[0]), sigmoidf_(v[1]), sigmoidf_(v[2]), sigmoidf_(v[3])}; }
__device__ __forceinline__ float gelu_tanh(float y) { const float z = 1.5957691216057308f * (y + 0.044715f * y * y * y); return y * sigmoidf_(z); }
__device__ __forceinline__ float wave_sum(float v) {
#pragma unroll
    for (int o = 1; o < 64; o <<= 1) v += __shfl_xor(v, o);
    return v;
}
__device__ __forceinline__ double dexp(double x) {
    const double k = __builtin_rint(x * 1.4426950408889634074); const double r = (x - k * 0.693147180369123816490) - k * 1.90821492927058770002e-10;
    double p = 1.0 / 87178291200.0;
    p = p * r + 1.0 / 6227020800.0; p = p * r + 1.0 / 479001600.0; p = p * r + 1.0 / 39916800.0; p = p * r + 1.0 / 3628800.0; p = p * r + 1.0 / 362880.0; p = p * r + 1.0 / 40320.0;
    p = p * r + 1.0 / 5040.0; p = p * r + 1.0 / 720.0; p = p * r + 1.0 / 120.0; p = p * r + 1.0 / 24.0; p = p * r + 1.0 / 6.0; p = p * r + 0.5; p = p * r + 1.0; p = p * r + 1.0;
    const long long e = (long long)k + 1023; const double sc = __builtin_bit_cast(double, (unsigned long long)e << 52);
    return p * sc;
}
__device__ __forceinline__ void dsincos(double a, double& s, double& c) {
    const double k = __builtin_rint(a * 0.63661977236758134308); const double r = (a - k * 1.57079632673412561417) - k * 6.07710050650619224932e-11;
    const double r2 = r * r;
    double ps = -1.0 / 1307674368000.0; ps = ps * r2 + 1.0 / 6227020800.0; ps = ps * r2 - 1.0 / 39916800.0; ps = ps * r2 + 1.0 / 362880.0; ps = ps * r2 - 1.0 / 5040.0; ps = ps * r2 + 1.0 / 120.0; ps = ps * r2 - 1.0 / 6.0; ps = ps * r2 + 1.0;
    const double sn = ps * r;
    double pc = 1.0 / 20922789888000.0; pc = pc * r2 - 1.0 / 87178291200.0; pc = pc * r2 + 1.0 / 479001600.0; pc = pc * r2 - 1.0 / 3628800.0; pc = pc * r2 + 1.0 / 40320.0; pc = pc * r2 - 1.0 / 720.0; pc = pc * r2 + 1.0 / 24.0; pc = pc * r2 - 0.5; pc = pc * r2 + 1.0;
    const int q = ((int)k) & 3;
    s = (q == 0) ? sn : (q == 1) ? pc : (q == 2) ? -sn : -pc;
    c = (q == 0) ? pc : (q == 1) ? -sn : (q == 2) ? -pc : sn;
}


__device__ __forceinline__ int lane_now() { int l = (int)__builtin_amdgcn_mbcnt_hi(~0u, __builtin_amdgcn_mbcnt_lo(~0u, 0u)); asm volatile("" : "+v"(l)); return l; }
#define XB_TMO      128
#define XB_XCNT(j)  (256  + 64 * (j))
#define XB_XSUB(j)  (1280 + 64 * (j))
#define XB_XGEN(j)  (2304 + 64 * (j))
#define XB_TOP      3328
#define XB_TOPGEN   3392
#define XCD_BAR_WORDS 3456
#define XB_SPIN_CAP (1u << 20)
__device__ __forceinline__ unsigned xb_ld(unsigned* p)              { return __hip_atomic_load(p, __ATOMIC_RELAXED, __HIP_MEMORY_SCOPE_AGENT); }
__device__ __forceinline__ unsigned xb_add(unsigned* p, unsigned v) { return __hip_atomic_fetch_add(p, v, __ATOMIC_RELAXED, __HIP_MEMORY_SCOPE_AGENT); }
__device__ __forceinline__ unsigned xb_xcc_id() { return (unsigned)__builtin_amdgcn_s_getreg((3 << 11) | 20) & 0xFu; }
#define XB_SPIN(cond, bar) do { unsigned _sp = 0; while (cond) { __builtin_amdgcn_s_sleep(1); \
    if ((++_sp & 255u) == 0u) { if (xb_ld(&(bar)[XB_TMO])) break; if (_sp > XB_SPIN_CAP) { atomicAdd(&(bar)[XB_TMO], 1u); break; } } } } while (0)
struct XcdBarrier { unsigned* bar; unsigned x; volatile LAS unsigned* st; int wave; };
__device__ __forceinline__ XcdBarrier xcd_barrier_post(unsigned* bar, volatile LAS unsigned* st, int wave) {
    XcdBarrier b; b.bar = bar; b.x = xb_xcc_id(); b.st = st; b.wave = wave;
    if (wave == 0 && lane_now() == 0) (void)xb_add(&bar[XB_XCNT(b.x)], 1u);
    return b;
}
__device__ __forceinline__ void xcd_barrier_complete(unsigned* bar, unsigned x, unsigned& nloc, unsigned& nx) {
    const unsigned G = gridDim.x * gridDim.y * gridDim.z;
    unsigned sum, cnt, mine, sp = 0u;
    for (;;) {
        sum = 0u; cnt = 0u; mine = 0u;
#pragma unroll
        for (unsigned j = 0; j < 16; ++j) { const unsigned c = xb_ld(&bar[XB_XCNT(j)]); sum += c; cnt += (c > 0u) ? 1u : 0u; mine = (j == x) ? c : mine; }
        if (sum == G) break;
        __builtin_amdgcn_s_sleep(1);
        if ((++sp & 255u) == 0u) { if (xb_ld(&bar[XB_TMO])) break; if (sp > XB_SPIN_CAP) { atomicAdd(&bar[XB_TMO], 1u); break; } }
    }
    nloc = mine > 0u ? mine : 1u; nx = cnt > 0u ? cnt : 1u;
}
__device__ __forceinline__ void xcd_barrier(const XcdBarrier& b) {
    asm volatile("s_waitcnt vmcnt(0)" ::: "memory");
    __syncthreads();
    if (b.wave == 0 && lane_now() == 0) {
        unsigned* bar = b.bar;
        __builtin_amdgcn_s_waitcnt(0);
        unsigned nloc = b.st[0], nx = b.st[1];
        if (nloc == 0u) { xcd_barrier_complete(bar, b.x, nloc, nx); b.st[0] = nloc; b.st[1] = nx; }
        const unsigned old = xb_add(&bar[XB_XSUB(b.x)], 1u);
        const unsigned gen = old / nloc;
        if (old + 1u == (gen + 1u) * nloc) {
            __builtin_amdgcn_fence(__ATOMIC_RELEASE, "agent");
            asm volatile("s_waitcnt vmcnt(0)" ::: "memory");
            const unsigned og = xb_add(&bar[XB_TOP], 1u);
            const unsigned tg = og / nx;
            if (og + 1u == (tg + 1u) * nx) xb_add(&bar[XB_TOPGEN], 1u);
            else XB_SPIN(xb_ld(&bar[XB_TOPGEN]) == tg, bar);
            __builtin_amdgcn_fence(__ATOMIC_ACQUIRE, "agent");
            xb_add(&bar[XB_XGEN(b.x)], 1u);
            asm volatile("s_waitcnt vmcnt(0)" ::: "memory");
        } else {
            XB_SPIN(xb_ld(&bar[XB_XGEN(b.x)]) == gen, bar);
            __builtin_amdgcn_fence(__ATOMIC_ACQUIRE, "agent");
            asm volatile("s_waitcnt vmcnt(0)" ::: "memory");
        }
    }
    __syncthreads();
}

struct Ctx {
    LAS unsigned char* lds; int wave, vcu, G;
    const float *x, *c, *w_mod, *b_mod, *g1, *w_in, *b_in, *lam_re, *lam_im, *log_dt, *b_re, *b_im, *c_re, *c_im, *ssm_d, *w_glu, *b_glu, *pool_w, *pool_scale, *p_ssm, *p_pool, *w_out, *g2,
        *rc_w, *rc_b, *rf_w, *rf_b, *moe_g, *moe_u, *moe_d, *gf;
    float* out; unsigned char* ws;
    unsigned* ctl; float* mod; f32x2* lpow; f32x2* bbar; float* ktab; int* tokslot; int* sorted; float* slotw; float* logits;
    bf16 *WinT, *WgluT, *PssmT, *WeffT, *WoutT, *WrB, *W1T, *WdT, *TG, *EtT; float* ssum; float* cbias;
    bf16 *h1, *u2, *u, *UX, *upool, *YZM, *P, *Q, *act, *ys; unsigned char *u2f8, *u8, *Wg8;
};

namespace pg8 {
constexpr int BM = 256, BK = 64, HALF = 128, HTB = HALF * BK * 2, STAGE_BYTES = 8 * HTB;
__device__ __forceinline__ int lds_byte(int r, int c) { const int st = (r >> 4) * 2 + (c >> 5), rr = r & 15, cc = c & 31, ob = rr * 64 + cc * 2; return st * 1024 + (ob ^ (((ob >> 9) & 1) << 5)); }
__device__ __forceinline__ void stage_rc(int b, int& R, int& C) { const int st = b / 1024, sb = b % 1024, swz = sb ^ (((sb >> 9) & 1) << 5); R = (st >> 1) * 16 + swz / 64; C = (st & 1) * 32 + (swz % 64) / 2; }
__device__ __forceinline__ int perm32(int rho) { const int n = rho >> 4, i = rho & 15; return 8 * (i >> 2) + 4 * n + (i & 3); }
struct Unit { const char* A; const char* B; const char* B1; int nt; int i0, i1, i2, i3; };

template <class Epi, class Sched, bool GATHER, bool ALIGN_EPI, bool SP2, bool F8 = false>
__device__ __forceinline__ void gemm_phase(LAS unsigned char* lds, const int wave, const int lda, const int ldb, const Sched& S, const Epi& E, const bool pre = false, const bool fol = false, const Unit* fu = nullptr, const int lda_f = 0, const int ldb_f = 0) {
    const int lane = lane_now(), wid = wave, tid = wid * 64 + lane, wr = wid >> 2, wc = wid & 3, fr = lane & 15, fq = lane >> 4;
    int RA[2], CA[2]; unsigned voffB[2], voffA[2][2], voffN[2][2];
#pragma unroll
    for (int i = 0; i < 2; ++i) { int R, C; stage_rc(tid * 16 + i * 8192, R, C); RA[i] = R; CA[i] = C; const int Rb = (R & ~31) + perm32(R & 31); voffB[i] = (unsigned)(Rb * ldb + C) * 2u;
        voffA[0][i] = (unsigned)(R * lda + C) * 2u; voffA[1][i] = (unsigned)((R + HALF) * lda + C) * 2u; voffN[0][i] = voffA[0][i]; voffN[1][i] = voffA[1][i]; }
    unsigned voffBf[2] = {0u, 0u}, voffAf[2][2] = {{0u, 0u}, {0u, 0u}};
    if (fol) {
#pragma unroll
        for (int i = 0; i < 2; ++i) { const int R = RA[i], C = CA[i], Rb = (R & ~31) + perm32(R & 31); voffBf[i] = (unsigned)(Rb * ldb_f + C) * 2u; voffAf[0][i] = (unsigned)(R * lda_f + C) * 2u; voffAf[1][i] = (unsigned)((R + HALF) * lda_f + C) * 2u; } }
    const size_t kstep = (size_t)(BK * 2);
    const unsigned ldsw = (unsigned)wid * 1024u;
    const int aoff = lds_byte(wr * 64 + fr, fq * 8), boff = lds_byte(wc * 32 + fr, fq * 8);
#define PG8_SA(b, h) (((b) * 2 + (h)) * HTB)
#define PG8_SB(b, h) ((4 + (b) * 2 + (h)) * HTB)
#define PG8_STAGE(bufoff, gbase, voff) do { const char* _gb = (const char*)(gbase); asm volatile("" : "+s"(_gb)); _Pragma("unroll") for (int _i = 0; _i < 2; ++_i) \
        __builtin_amdgcn_global_load_lds((const unsigned*)(_gb + (voff)[_i]), (LAS unsigned*)(lds + (bufoff) + ldsw + _i * 8192), 16, 0, 0); } while (0)
#define PG8_LD16(p) (*(const LAS i32x4_t*)(p))
#define PG8_LDA(dst, b, h) do { if constexpr (F8) { _Pragma("unroll") for (int m = 0; m < 4; ++m) { const i32x4_t _l = PG8_LD16(lds + PG8_SA(b, h) + aoff + m * 2048), _h = PG8_LD16(lds + PG8_SA(b, h) + aoff + m * 2048 + 1024); dst##8[m] = __builtin_shufflevector(_l, _h, 0, 1, 2, 3, 4, 5, 6, 7); } } \
        else { _Pragma("unroll") for (int m = 0; m < 4; ++m) _Pragma("unroll") for (int k = 0; k < 2; ++k) dst[m][k] = *(const LAS bf16x8*)(lds + PG8_SA(b, h) + aoff + m * 2048 + k * 1024); } } while (0)
#define PG8_LDB(dst, b, h) do { if constexpr (F8) { _Pragma("unroll") for (int n = 0; n < 2; ++n) { const i32x4_t _l = PG8_LD16(lds + PG8_SB(b, h) + boff + n * 2048), _h = PG8_LD16(lds + PG8_SB(b, h) + boff + n * 2048 + 1024); dst##8[n] = __builtin_shufflevector(_l, _h, 0, 1, 2, 3, 4, 5, 6, 7); } } \
        else { _Pragma("unroll") for (int n = 0; n < 2; ++n) _Pragma("unroll") for (int k = 0; k < 2; ++k) dst[n][k] = *(const LAS bf16x8*)(lds + PG8_SB(b, h) + boff + n * 2048 + k * 1024); } } while (0)
#define PG8_MMA(ai, bj, At, Bt) do { __builtin_amdgcn_s_setprio(1); if constexpr (F8) { _Pragma("unroll") for (int m = 0; m < 4; ++m) _Pragma("unroll") for (int n = 0; n < 2; ++n) \
        asm volatile("v_mfma_scale_f32_16x16x128_f8f6f4 %0, %1, %2, %0, %3, %3 op_sel_hi:[0,0,0]" : "+v"(acc[ai][bj][m][n]) : "v"(Bt##8[n]), "v"(At##8[m]), "v"(sc127)); } \
        else { _Pragma("unroll") for (int m = 0; m < 4; ++m) _Pragma("unroll") for (int n = 0; n < 2; ++n) _Pragma("unroll") for (int k = 0; k < 2; ++k) \
        acc[ai][bj][m][n] = __builtin_amdgcn_mfma_f32_16x16x32_bf16(Bt[n][k], At[m][k], acc[ai][bj][m][n], 0, 0, 0); } __builtin_amdgcn_s_setprio(0); } while (0)
#define PG8_WAIT_V(n) asm volatile("s_waitcnt vmcnt(" #n ")" ::: "memory")
#define PG8_WAIT_L(n) asm volatile("s_waitcnt lgkmcnt(" #n ")" ::: "memory")
#define PG8_BAR __builtin_amdgcn_s_barrier()
#define PG8_SCHED __builtin_amdgcn_sched_barrier(0)
    Unit cur, nxt; int ui = 0;
    if (!S.next(0, cur)) return;
    f32x4 acc[2][2][4][2];
#pragma unroll
    for (int a = 0; a < 2; ++a)
#pragma unroll
        for (int b = 0; b < 2; ++b)
#pragma unroll
            for (int m = 0; m < 4; ++m)
#pragma unroll
                for (int n = 0; n < 2; ++n) acc[a][b][m][n] = (f32x4){0.f, 0.f, 0.f, 0.f};
    typedef int i32x4_t __attribute__((ext_vector_type(4))); typedef int i32x8_t __attribute__((ext_vector_type(8)));
    bf16x8 At[4][2], B0[2][2], B1[2][2]; i32x8_t At8[4], B08[2], B18[2]; int sc127 = 0x7f7f7f7f; asm volatile("" : "+v"(sc127));
    if constexpr (GATHER) {
#pragma unroll
        for (int h = 0; h < 2; ++h)
#pragma unroll
            for (int i = 0; i < 2; ++i) voffA[h][i] = S.row_off(cur, RA[i] + h * HALF) + (unsigned)CA[i] * 2u;
        asm volatile("s_waitcnt vmcnt(0)" ::: "memory");
    }
    const char* cA = cur.A; const char* cB = cur.B; const char* cB1 = cur.B1;
    if (pre) { if (wr == 1) PG8_BAR; }
    else if constexpr (SP2) {
        PG8_STAGE(PG8_SB(0, 0), cB, voffB); PG8_STAGE(PG8_SB(0, 1), cB1, voffB); PG8_STAGE(PG8_SA(0, 0), cA, voffA[0]); PG8_STAGE(PG8_SA(0, 1), cA, voffA[1]);
        if (wr == 1) PG8_BAR;
        PG8_WAIT_V(2); PG8_BAR;
        PG8_STAGE(PG8_SB(1, 0), cB + kstep, voffB); PG8_STAGE(PG8_SA(1, 0), cA + kstep, voffA[0]); PG8_STAGE(PG8_SB(1, 1), cB1 + kstep, voffB);
        PG8_WAIT_V(6); PG8_BAR;
    } else {
        PG8_STAGE(PG8_SB(0, 0), cB, voffB); PG8_STAGE(PG8_SA(0, 0), cA, voffA[0]); PG8_STAGE(PG8_SB(0, 1), cB1, voffB); PG8_STAGE(PG8_SA(0, 1), cA, voffA[1]);
        if (wr == 1) PG8_BAR;
        PG8_WAIT_V(4); PG8_BAR;
        PG8_STAGE(PG8_SB(1, 0), cB + kstep, voffB); PG8_STAGE(PG8_SA(1, 0), cA + kstep, voffA[0]); PG8_STAGE(PG8_SB(1, 1), cB1 + kstep, voffB);
        PG8_WAIT_V(6); PG8_BAR;
    }
    for (;;) {
        const bool has_next = S.next(ui + 1, nxt);
        if constexpr (GATHER) {
            if (has_next) {
#pragma unroll
                for (int h = 0; h < 2; ++h)
#pragma unroll
                    for (int i = 0; i < 2; ++i) voffN[h][i] = S.row_off(nxt, RA[i] + h * HALF) + (unsigned)CA[i] * 2u;
            } else {
#pragma unroll
                for (int h = 0; h < 2; ++h)
#pragma unroll
                    for (int i = 0; i < 2; ++i) voffN[h][i] = voffA[h][i];
            }
            asm volatile("s_waitcnt vmcnt(0)" : "+v"(voffN[0][0]), "+v"(voffN[0][1]), "+v"(voffN[1][0]), "+v"(voffN[1][1]) :: "memory");
        }
        const bool usef = fol && !has_next;
        const char* nA = has_next ? nxt.A : (usef ? fu->A : cA); const char* nB = has_next ? nxt.B : (usef ? fu->B : cB); const char* nB1 = has_next ? nxt.B1 : (usef ? fu->B1 : cB1);
        const int nt = cur.nt;
        for (int t = 0; t < nt; t += 2) {
            const bool last = (t == nt - 2);
            const char* a1 = cA + (size_t)(t + 1) * kstep;
            const char* a2 = last ? nA : cA + (size_t)(t + 2) * kstep; const char* b2 = last ? nB : cB + (size_t)(t + 2) * kstep;
            const char* a3 = a2 + kstep; const char* b3 = b2 + kstep;
            const char* b2h = last ? nB1 : cB1 + (size_t)(t + 2) * kstep; const char* b3h = b2h + kstep;
            unsigned vA2[2][2];
#pragma unroll
            for (int h = 0; h < 2; ++h)
#pragma unroll
                for (int i = 0; i < 2; ++i) vA2[h][i] = (GATHER && last) ? voffN[h][i] : ((usef && last) ? voffAf[h][i] : voffA[h][i]);
            unsigned vB2[2];
#pragma unroll
            for (int i = 0; i < 2; ++i) vB2[i] = (usef && last) ? voffBf[i] : voffB[i];
            if constexpr (SP2) {
            PG8_LDB(B0, 0, 0); PG8_LDB(B1, 0, 1); PG8_SCHED; PG8_LDA(At, 0, 0); PG8_STAGE(PG8_SA(1, 1), a1, voffA[1]);
            PG8_WAIT_V(8); PG8_WAIT_L(0); PG8_BAR; PG8_MMA(0, 0, At, B0); PG8_MMA(0, 1, At, B1); PG8_BAR; PG8_SCHED;
            PG8_LDA(At, 0, 1); PG8_STAGE(PG8_SB(0, 0), b2, vB2); PG8_STAGE(PG8_SB(0, 1), b2h, vB2); PG8_STAGE(PG8_SA(0, 0), a2, vA2[0]);
            PG8_WAIT_V(8); PG8_WAIT_L(0); PG8_BAR; PG8_MMA(1, 0, At, B0); PG8_MMA(1, 1, At, B1); PG8_BAR; PG8_SCHED;
            PG8_LDB(B0, 1, 0); PG8_LDB(B1, 1, 1); PG8_SCHED; PG8_LDA(At, 1, 0); PG8_STAGE(PG8_SA(0, 1), a2, vA2[1]);
            PG8_WAIT_V(8); PG8_WAIT_L(0); PG8_BAR; PG8_MMA(0, 0, At, B0); PG8_MMA(0, 1, At, B1); PG8_BAR; PG8_SCHED;
            PG8_LDA(At, 1, 1); PG8_STAGE(PG8_SB(1, 0), b3, vB2); PG8_STAGE(PG8_SB(1, 1), b3h, vB2); PG8_STAGE(PG8_SA(1, 0), a3, vA2[0]);
            PG8_WAIT_V(8); PG8_WAIT_L(0); PG8_BAR; PG8_MMA(1, 0, At, B0); PG8_MMA(1, 1, At, B1); PG8_BAR; PG8_SCHED;
            } else {
            PG8_LDB(B0, 0, 0); PG8_SCHED; PG8_LDA(At, 0, 0); PG8_STAGE(PG8_SA(1, 1), a1, voffA[1]);
            PG8_WAIT_L(8); PG8_BAR; PG8_WAIT_L(0); PG8_MMA(0, 0, At, B0); PG8_BAR; PG8_SCHED;
            PG8_LDB(B1, 0, 1); PG8_STAGE(PG8_SB(0, 0), b2, voffB);
            PG8_BAR; PG8_WAIT_L(0); PG8_MMA(0, 1, At, B1); PG8_BAR;
            PG8_LDA(At, 0, 1); PG8_STAGE(PG8_SA(0, 0), a2, vA2[0]);
            PG8_BAR; PG8_WAIT_L(0); PG8_MMA(1, 0, At, B0); PG8_BAR; PG8_SCHED;
            PG8_STAGE(PG8_SB(0, 1), b2h, voffB);
            PG8_WAIT_V(6); PG8_BAR; PG8_MMA(1, 1, At, B1); PG8_BAR;
            PG8_LDB(B0, 1, 0); PG8_SCHED; PG8_LDA(At, 1, 0); PG8_STAGE(PG8_SA(0, 1), a2, vA2[1]);
            PG8_WAIT_L(8); PG8_BAR; PG8_WAIT_L(0); PG8_MMA(0, 0, At, B0); PG8_BAR; PG8_SCHED;
            PG8_LDB(B1, 1, 1); PG8_STAGE(PG8_SB(1, 0), b3, voffB);
            PG8_BAR; PG8_WAIT_L(0); PG8_MMA(0, 1, At, B1); PG8_BAR;
            PG8_LDA(At, 1, 1); PG8_STAGE(PG8_SA(1, 0), a3, vA2[0]);
            PG8_BAR; PG8_WAIT_L(0); PG8_MMA(1, 0, At, B0); PG8_BAR; PG8_SCHED;
            PG8_STAGE(PG8_SB(1, 1), b3h, voffB);
            PG8_WAIT_V(6); PG8_BAR; PG8_MMA(1, 1, At, B1); PG8_BAR;
            }
        }
        if constexpr (F8) asm volatile("s_nop 15\n\ts_nop 15" ::: "memory");
        if constexpr (ALIGN_EPI) { if (wr == 0) PG8_BAR; }
        { int r0 = wr * 64 + fr, c0 = wc * 32 + 8 * fq; asm volatile("" : "+v"(r0), "+v"(c0));
        typename Epi::Col colv[2];
        colv[0] = E.col(cur, c0); if constexpr (!Epi::PAIR) colv[1] = E.col(cur, HALF + c0);
#pragma unroll
        for (int ai = 0; ai < 2; ++ai)
#pragma unroll
            for (int mb = 0; mb < 4; mb += Epi::MB) {
                if constexpr (Epi::PAIR) {
                    typename Epi::Pre pre[Epi::MB];
#pragma unroll
                    for (int m = 0; m < Epi::MB; ++m) pre[m] = E.pre(cur, ai * HALF + (mb + m) * 16 + r0, c0);
#pragma unroll
                    for (int m = 0; m < Epi::MB; ++m) E.pair(cur, ai * HALF + (mb + m) * 16 + r0, c0, acc[ai][0][mb + m][0], acc[ai][0][mb + m][1], acc[ai][1][mb + m][0], acc[ai][1][mb + m][1], pre[m], colv[0]);
                } else {
                typename Epi::Pre pre[Epi::MB][2];
#pragma unroll
                for (int m = 0; m < Epi::MB; ++m)
#pragma unroll
                    for (int bj = 0; bj < 2; ++bj) pre[m][bj] = E.pre(cur, ai * HALF + (mb + m) * 16 + r0, bj * HALF + c0);
#pragma unroll
                for (int m = 0; m < Epi::MB; ++m)
#pragma unroll
                    for (int bj = 0; bj < 2; ++bj) E(cur, ai * HALF + (mb + m) * 16 + r0, bj * HALF + c0, acc[ai][bj][mb + m][0], acc[ai][bj][mb + m][1], pre[m][bj], colv[bj]);
                }
                asm volatile("" ::: "memory"); } }
        if (!has_next) break;
#pragma unroll
        for (int a = 0; a < 2; ++a)
#pragma unroll
            for (int b = 0; b < 2; ++b)
#pragma unroll
                for (int m = 0; m < 4; ++m)
#pragma unroll
                    for (int n = 0; n < 2; ++n) acc[a][b][m][n] = (f32x4){0.f, 0.f, 0.f, 0.f};
        cur = nxt; cA = nA; cB = nB; cB1 = nB1; ++ui;
        if constexpr (GATHER) {
#pragma unroll
            for (int h = 0; h < 2; ++h)
#pragma unroll
                for (int i = 0; i < 2; ++i) voffA[h][i] = voffN[h][i];
        }
        if constexpr (ALIGN_EPI) { if (wr == 1) PG8_BAR; }
    }
    PG8_WAIT_V(0);
    if constexpr (!ALIGN_EPI) { if (wr == 0) PG8_BAR; }
    PG8_BAR;
#undef PG8_SA
#undef PG8_SB
#undef PG8_STAGE
#undef PG8_LD16
#undef PG8_LDA
#undef PG8_LDB
#undef PG8_MMA
#undef PG8_WAIT_V
#undef PG8_WAIT_L
#undef PG8_BAR
#undef PG8_SCHED
}
}
#ifndef PG8_SP2
#define PG8_SP2 true
#endif
#ifndef PG8_ALIGN
#define PG8_ALIGN true
#endif

template <class NMap>
__device__ __forceinline__ void transpose_item(const float* W, int N, bf16* WT, int ldd, LAS float* scr, int k0, int n0, int lane, NMap nmap) {
    f32x4 v[16];
#pragma unroll
    for (int i = 0; i < 16; ++i) v[i] = *(const f32x4*)(W + (size_t)(k0 + 4 * i + (lane >> 4)) * N + n0 + 4 * (lane & 15));
#pragma unroll
    for (int i = 0; i < 16; ++i) { LAS float* d = scr + (4 * i + (lane >> 4)) * 65 + 4 * (lane & 15); d[0] = v[i].x; d[1] = v[i].y; d[2] = v[i].z; d[3] = v[i].w; }
    LDS_WAIT();
    const int c = lane & 7;
#pragma unroll
    for (int j = 0; j < 8; ++j) { const int n = (lane >> 3) + 8 * j; const LAS float* q = scr + (8 * c) * 65 + n;
        u32x4 o; o.x = pk2(q[0 * 65], q[1 * 65]); o.y = pk2(q[2 * 65], q[3 * 65]); o.z = pk2(q[4 * 65], q[5 * 65]); o.w = pk2(q[6 * 65], q[7 * 65]);
        *(u32x4*)(WT + (size_t)nmap(n0 + n) * ldd + k0 + 8 * c) = o; }
    LDS_WAIT();
}
template <class NMap>
__device__ __forceinline__ void transpose_item_f8(const float* W, int N, unsigned char* WT, int ldd, LAS float* scr, int k0, int n0, int lane, NMap nmap) {
    f32x4 v[16];
#pragma unroll
    for (int i = 0; i < 16; ++i) v[i] = *(const f32x4*)(W + (size_t)(k0 + 4 * i + (lane >> 4)) * N + n0 + 4 * (lane & 15));
#pragma unroll
    for (int i = 0; i < 16; ++i) { LAS float* d = scr + (4 * i + (lane >> 4)) * 65 + 4 * (lane & 15); d[0] = v[i].x; d[1] = v[i].y; d[2] = v[i].z; d[3] = v[i].w; }
    LDS_WAIT();
    const int c = lane & 7;
#pragma unroll
    for (int j = 0; j < 8; ++j) { const int n = (lane >> 3) + 8 * j; const LAS float* q = scr + (8 * c) * 65 + n;
        u32x2 o; o.x = pk4f8((f32x4){q[0 * 65], q[1 * 65], q[2 * 65], q[3 * 65]} * W8_SCALE); o.y = pk4f8((f32x4){q[4 * 65], q[5 * 65], q[6 * 65], q[7 * 65]} * W8_SCALE);
        *(u32x2*)(WT + (size_t)nmap(n0 + n) * ldd + k0 + 8 * c) = o; }
    LDS_WAIT();
}
struct NId { __device__ __forceinline__ int operator()(int n) const { return n; } };
struct NSub { int off; __device__ __forceinline__ int operator()(int n) const { return n - off; } };
struct NGateUp { int up; __device__ __forceinline__ int operator()(int a) const { return a + DE * up; } };

__device__ __forceinline__ void p0_prep(const Ctx& X) {
    const int gw = X.vcu * NWAVES + X.wave, NGW = X.G * NWAVES; const int gt = X.vcu * NTHR + (X.wave * 64 + lane_now()), NGT = X.G * NTHR;
    {
        LAS float* red = (LAS float*)X.lds;
        const int lane = lane_now(), fr = lane & 15, fq = lane >> 4, w = X.wave;
        for (int cg = X.vcu; cg < NMOD / 32; cg += X.G) {
            f32x4 acc[2][2];
#pragma unroll
            for (int a = 0; a < 2; ++a)
#pragma unroll
                for (int b = 0; b < 2; ++b) acc[a][b] = (f32x4){0.f, 0.f, 0.f, 0.f};
#pragma unroll 1
            for (int ks = 0; ks < 4; ++ks) { const int k0 = 128 * w + 32 * ks + 8 * fq;
                bf16x8 whi[2], wlo[2], chi[2], clo[2];
#pragma unroll
                for (int h = 0; h < 2; ++h) { float wv[8], cv[8];
#pragma unroll
                    for (int j = 0; j < 8; ++j) wv[j] = X.w_mod[(size_t)(k0 + j) * NMOD + cg * 32 + 16 * h + fr];
                    const f32x4 c0 = *(const f32x4*)(X.c + (size_t)(16 * h + fr) * D + k0), c1 = *(const f32x4*)(X.c + (size_t)(16 * h + fr) * D + k0 + 4);
#pragma unroll
                    for (int j = 0; j < 4; ++j) { cv[j] = c0[j] * sigmoidf_(c0[j]); cv[4 + j] = c1[j] * sigmoidf_(c1[j]); }
#pragma unroll
                    for (int j = 0; j < 8; ++j) { const unsigned hw = f2bf(wv[j]), hc = f2bf(cv[j]); whi[h][j] = (short)hw; chi[h][j] = (short)hc;
                        wlo[h][j] = (short)f2bf(wv[j] - __builtin_bit_cast(float, hw << 16)); clo[h][j] = (short)f2bf(cv[j] - __builtin_bit_cast(float, hc << 16)); } }
#pragma unroll
                for (int a = 0; a < 2; ++a)
#pragma unroll
                    for (int b = 0; b < 2; ++b) { acc[a][b] = __builtin_amdgcn_mfma_f32_16x16x32_bf16(whi[a], chi[b], acc[a][b], 0, 0, 0);
                        acc[a][b] = __builtin_amdgcn_mfma_f32_16x16x32_bf16(whi[a], clo[b], acc[a][b], 0, 0, 0); acc[a][b] = __builtin_amdgcn_mfma_f32_16x16x32_bf16(wlo[a], chi[b], acc[a][b], 0, 0, 0); } }
            __syncthreads();
#pragma unroll
            for (int a = 0; a < 2; ++a)
#pragma unroll
                for (int b = 0; b < 2; ++b)
#pragma unroll
                    for (int r = 0; r < 4; ++r) red[(w * 32 + 16 * a + 4 * fq + r) * 32 + 16 * b + fr] = acc[a][b][r];
            __syncthreads();
            for (int o = w * 64 + lane; o < NB * 32; o += NTHR) { const int n = o >> 5, b = o & 31; float sm = 0.f;
#pragma unroll
                for (int q = 0; q < 8; ++q) sm += red[(q * 32 + n) * 32 + b];
                X.mod[(size_t)b * NMOD + cg * 32 + n] = sm + X.b_mod[cg * 32 + n]; }
        }
        __syncthreads();
    }
    {
        LAS float* scr = (LAS float*)(X.lds + X.wave * 16640);
        constexpr int I_IN = (D / 64) * (DIN / 64), I_GLU = (DSSM / 64) * (DSSM / 64), I_PS = (DSSM / 64) * (D / 64), I_WO = (D / 64) * (D / 64), I_G8 = (D / 64) * (2048 / 64);
        constexpr int NITEMS = I_IN + I_GLU + I_PS + I_WO + I_G8;
        for (int it = gw; it < NITEMS; it += NGW) {
            int r = it;
            if (r < I_IN) { const int nb = DIN / 64; transpose_item(X.w_in, DIN, X.WinT, D, scr, 64 * (r / nb), 64 * (r % nb), lane_now(), NId{}); continue; } r -= I_IN;
            if (r < I_GLU) { const int nb = DSSM / 64; transpose_item(X.w_glu, DSSM, X.WgluT, D, scr, 64 * (r / nb), 64 * (r % nb), lane_now(), NId{}); continue; } r -= I_GLU;
            if (r < I_PS) { const int nb = D / 64; transpose_item(X.p_ssm, D, X.PssmT, D, scr, 64 * (r / nb), 64 * (r % nb), lane_now(), NId{}); continue; } r -= I_PS;
            if (r < I_WO) { const int nb = D / 64; transpose_item(X.w_out, D, X.WoutT, D, scr, 64 * (r / nb), 64 * (r % nb), lane_now(), NId{}); continue; } r -= I_WO;
            { const int nb = 2048 / 64; transpose_item_f8(X.w_in, DIN, X.Wg8, D, scr, 64 * (r / nb), 768 + 64 * (r % nb), lane_now(), NSub{768}); }
        }
    }
    for (int i = gt; i < (D / 4) * DPOOL; i += NGT) { const int n4 = (i & 255) * 4, gc = i >> 8, g = gc >> 7; const float* pw = X.pool_w + (size_t)gc * 128;
        float s0 = 0.f, s1 = 0.f, s2 = 0.f, s3 = 0.f;
#pragma unroll 1
        for (int d0 = 0; d0 < 128; d0 += 16) { float4 pv[16];
#pragma unroll
            for (int j = 0; j < 16; ++j) pv[j] = *(const float4*)(X.p_pool + (size_t)(g * 128 + d0 + j) * D + n4);
#pragma unroll
            for (int j = 0; j < 16; ++j) { const float w = pw[d0 + j] * X.pool_scale[g * 128 + d0 + j];
                s0 += w * pv[j].x; s1 += w * pv[j].y; s2 += w * pv[j].z; s3 += w * pv[j].w; } }
        X.WeffT[(size_t)(n4 + 0) * D + gc] = (bf16)f2bf(s0); X.WeffT[(size_t)(n4 + 1) * D + gc] = (bf16)f2bf(s1);
        X.WeffT[(size_t)(n4 + 2) * D + gc] = (bf16)f2bf(s2); X.WeffT[(size_t)(n4 + 3) * D + gc] = (bf16)f2bf(s3); }
    for (int i = gt; i < NG * NP; i += NGT) { const int g = i >> 6;
        const double dt = dexp((double)X.log_dt[g]), lr = (double)X.lam_re[i], li = (double)X.lam_im[i];
        const double mag = dexp(lr * dt); double sn, cs; dsincos(li * dt, sn, cs); const double br = mag * cs, bi = mag * sn;
        double wr = 1.0, wi = 0.0;
        for (int m = 0; m <= CH; ++m) { X.lpow[((size_t)g * 65 + m) * NP + (i & 63)] = (f32x2){(float)wr, (float)wi}; const double nr = wr * br - wi * bi; wi = wr * bi + wi * br; wr = nr; }
        const double den = lr * lr + li * li, nr1 = br - 1.0, fr_ = (nr1 * lr + bi * li) / den, fi_ = (bi * lr - nr1 * li) / den;
        for (int h = 0; h < GH; ++h) { const double b_r = (double)X.b_re[(size_t)i * GH + h], b_i = (double)X.b_im[(size_t)i * GH + h];
            X.bbar[(size_t)i * GH + h] = (f32x2){(float)(fr_ * b_r - fi_ * b_i), (float)(fr_ * b_i + fi_ * b_r)}; }
    }
    {
        LAS f32x2* lp = (LAS f32x2*)X.lds; LAS f32x2* bb = lp + 64;
        LAS double* fz = (LAS double*)(X.lds + 16384);
        for (int it = X.vcu; it < NG * CH; it += X.G) { const int g = it / CH, m = it % CH;
            __syncthreads();
            if ((X.wave * 64 + lane_now()) < NP) { const int i = g * NP + (X.wave * 64 + lane_now()); const double dt = dexp((double)X.log_dt[g]), lr = (double)X.lam_re[i], li = (double)X.lam_im[i];
                const double mag1 = dexp(lr * dt); double sn1, cs1; dsincos(li * dt, sn1, cs1); const double br = mag1 * cs1, bi = mag1 * sn1;
                const double den = lr * lr + li * li, nr1 = br - 1.0; fz[2 * (X.wave * 64 + lane_now())] = (nr1 * lr + bi * li) / den; fz[2 * (X.wave * 64 + lane_now()) + 1] = (bi * lr - nr1 * li) / den;
                const double magm = dexp(lr * dt * m); double sn, cs; dsincos(li * dt * m, sn, cs); lp[(X.wave * 64 + lane_now())] = (f32x2){(float)(magm * cs), (float)(magm * sn)}; }
            __syncthreads();
            for (int q = (X.wave * 64 + lane_now()); q < NP * GH; q += NTHR) { const int p = q >> 4; const size_t i = (size_t)(g * NP) * GH + q; const double b_r = (double)X.b_re[i], b_i = (double)X.b_im[i], fr_ = fz[2 * p], fi_ = fz[2 * p + 1];
                bb[q] = (f32x2){(float)(fr_ * b_r - fi_ * b_i), (float)(fr_ * b_i + fi_ * b_r)}; }
            __syncthreads();
            if ((X.wave * 64 + lane_now()) < 256) { const int h = (X.wave * 64 + lane_now()) >> 4, h2 = (X.wave * 64 + lane_now()) & 15; float s = 0.f;
                for (int p0 = 0; p0 < NP; p0 += 16) { float crv[16], civ[16];
#pragma unroll
                    for (int j = 0; j < 16; ++j) { crv[j] = X.c_re[(size_t)(g * GH + h) * NP + p0 + j]; civ[j] = X.c_im[(size_t)(g * GH + h) * NP + p0 + j]; }
#pragma unroll
                    for (int j = 0; j < 16; ++j) { const f32x2 l = lp[p0 + j], b = bb[(p0 + j) * GH + h2]; const float tr = crv[j] * l.x - civ[j] * l.y, ti = crv[j] * l.y + civ[j] * l.x; s += tr * b.x - ti * b.y; } }
                X.ktab[((size_t)(g * CH + m) * GH + h) * GH + h2] = s; }
        }
        __syncthreads();
    }
}

#ifndef FAST_P1
#define FAST_P1 1
#endif
#ifndef FAST_P2
#define FAST_P2 1
#endif
#ifndef FAST_P3
#define FAST_P3 1
#endif
#ifndef FAST_P4
#define FAST_P4 1
#endif
#ifndef FAST_P5
#define FAST_P5 1
#endif
using pg8::Unit;
template <bool FAST, bool GATHER, class Epi, class Sched, bool F8 = false>
__device__ __forceinline__ void run_gemm(const Ctx& X, int lda, int ldb, const Sched& S, const Epi& E, const bool pre = false, const bool fol = false, const Unit* fu = nullptr, const int lda_f = 0, const int ldb_f = 0) {
    static_assert(FAST, "the checkpoint (simple) GEMM core was removed from this build");
    pg8::gemm_phase<Epi, Sched, GATHER, PG8_ALIGN, PG8_SP2, F8>(X.lds, X.wave, lda, ldb, S, E, pre, fol, fu, lda_f, ldb_f);
}
struct SchedTileN { const char* A; const char* B; size_t bstep; int n, nt; size_t bhalf;
    __device__ __forceinline__ bool next(int i, Unit& u) const { if (i >= n) return false; u.A = A; u.B = B + (size_t)i * bstep; u.B1 = u.B + bhalf; u.nt = nt; u.i0 = i; u.i1 = 0; u.i2 = 0; u.i3 = 0; return true; }
    __device__ __forceinline__ unsigned row_off(const Unit&, int) const { return 0u; } };

struct NoPre {};
struct EpiInProj { bf16* UX; bf16* upool; const float* b_in; int tile;
    static constexpr int MB = 4; static constexpr bool PAIR = false;
    typedef NoPre Pre; struct Col { f32x4 b0, b1; };
    __device__ __forceinline__ Col col(const Unit& u, int c) const { const int cc = u.i0 * 256 + c; return Col{*(const f32x4*)(b_in + cc), *(const f32x4*)(b_in + cc + 4)}; }
    __device__ __forceinline__ Pre pre(const Unit&, int, int) const { return Pre{}; }
    __device__ __forceinline__ void operator()(const Unit& u, int r, int c, f32x4 v0, f32x4 v1, const Pre&, const Col& k) const {
        const int pn = u.i0, col = pn * 256 + c, tok = tile * 256 + r;
        v0 += k.b0; v1 += k.b1;
        bf16* dst;
        if (pn == 0) { const int g = col >> 4, h0 = col & 15, ci = tok / CH, s = tok % CH; dst = UX + ((size_t)(g * NCOL + ci) * KX + 128 + s * 16 + h0); }
        else dst = upool + (size_t)tok * DPOOL + (col - DSSM);
        *(u32x4*)dst = pack8(v0, v1);
    } };

__device__ __forceinline__ void p1_rows(const Ctx& X, int tile) {
    const int b = tile >> 3; const float* md = X.mod + (size_t)b * NMOD;
    f32x4 sc[4], sh[4];
#pragma unroll
    for (int j = 0; j < 4; ++j) { const int c0 = 4 * lane_now() + 256 * j; const f32x4 g = *(const f32x4*)(X.g1 + c0), s1 = *(const f32x4*)(md + D + c0); sc[j] = g * (s1 + 1.0f); sh[j] = *(const f32x4*)(md + c0); }
    for (int r4 = X.wave; r4 < 256; r4 += 4 * NWAVES) {
        f32x4 v[4][4];
#pragma unroll
        for (int k = 0; k < 4; ++k) { const f32x4* xr = (const f32x4*)(X.x + ((size_t)tile * 256 + r4 + 8 * k) * D) + lane_now();
#pragma unroll
            for (int j = 0; j < 4; ++j) v[k][j] = xr[64 * j]; }
#pragma unroll
        for (int k = 0; k < 4; ++k) { float s = 0.f;
#pragma unroll
            for (int j = 0; j < 4; ++j) s += (v[k][j].x * v[k][j].x + v[k][j].y * v[k][j].y) + (v[k][j].z * v[k][j].z + v[k][j].w * v[k][j].w);
            const float rstd = 1.0f / sqrtf(wave_sum(s) * (1.0f / D) + EPS);
            u32x2* o = (u32x2*)(X.u + ((size_t)tile * 256 + r4 + 8 * k) * D) + lane_now();
            unsigned* o8 = (unsigned*)(X.u8 + ((size_t)tile * 256 + r4 + 8 * k) * D) + lane_now();
#pragma unroll
            for (int j = 0; j < 4; ++j) { const f32x4 y = v[k][j] * rstd * sc[j] + sh[j]; u32x2 w; w.x = pk2(y.x, y.y); w.y = pk2(y.z, y.w); o[64 * j] = w; o8[64 * j] = pk4f8(y * A8_SCALE); } }
    }
}
__device__ __forceinline__ void p1_tables(const Ctx& X) {
    const int gt = X.vcu * NTHR + (X.wave * 64 + lane_now()), NGT = X.G * NTHR;
    for (int q = gt; q < NG * CHGH * CH; q += NGT) { const int s_ = q % CH, row = q / CH, g = row / CHGH, j = (row >> 4) % CH, h = row & 15, m = (s_ <= j) ? (j - s_) : 0;
        const f32x4* kt = (const f32x4*)(X.ktab + ((size_t)(g * CH + m) * GH + h) * GH); const float ok = (s_ <= j) ? 1.f : 0.f;
        const f32x4 v0 = kt[0], v1 = kt[1], v2 = kt[2], v3 = kt[3];
        u32x4* o = (u32x4*)(X.TG + (size_t)row * KX + 128 + s_ * 16); o[0] = pack8(v0 * ok, v1 * ok); o[1] = pack8(v2 * ok, v3 * ok); }
    for (int q = gt; q < NG * CHGH * 16; q += NGT) { const int kc = q & 15, row = q >> 4, g = row / CHGH, j = (row >> 4) % CH, h = row & 15, k0 = 8 * kc;
        float v[8];
#pragma unroll
        for (int i = 0; i < 8; ++i) { const int pp = k0 + i, p = pp & 63; const float cr = X.c_re[(size_t)(g * GH + h) * NP + p], ci = X.c_im[(size_t)(g * GH + h) * NP + p]; const f32x2 l = X.lpow[((size_t)g * 65 + j + 1) * NP + p];
            v[i] = (pp < 64) ? (cr * l.x - ci * l.y) : -(cr * l.y + ci * l.x); }
        u32x4 w; w.x = pk2(v[0], v[1]); w.y = pk2(v[2], v[3]); w.z = pk2(v[4], v[5]); w.w = pk2(v[6], v[7]);
        *(u32x4*)(X.TG + (size_t)row * KX + k0) = w; }
    for (int q = gt; q < NG * 256 * (CHGH / 8); q += NGT) { const int kc = q % (CHGH / 8), row = q / (CHGH / 8), g = row >> 8, pp = row & 255, k0 = 8 * kc, s = k0 >> 4, h0 = k0 & 15;
        float v[8];
        if (pp < 128) { const int p = pp & 63; const f32x2 l = X.lpow[((size_t)g * 65 + (CH - 1 - s)) * NP + p];
#pragma unroll
            for (int i = 0; i < 8; ++i) { const f32x2 b = X.bbar[(size_t)(g * NP + p) * GH + h0 + i]; v[i] = (pp < 64) ? (l.x * b.x - l.y * b.y) : (l.x * b.y + l.y * b.x); } }
        else {
#pragma unroll
            for (int i = 0; i < 8; ++i) v[i] = 0.f; }
        u32x4 w; w.x = pk2(v[0], v[1]); w.y = pk2(v[2], v[3]); w.z = pk2(v[4], v[5]); w.w = pk2(v[6], v[7]);
        *(u32x4*)(X.EtT + (size_t)row * CHGH + k0) = w; }
}
__device__ __forceinline__ void p1_router_fold(const Ctx& X) {
    const int gt = X.vcu * NTHR + (X.wave * 64 + lane_now()), NGT = X.G * NTHR; const int gw = X.vcu * NWAVES + X.wave, NGW = X.G * NWAVES;
    for (int i = gt; i < NB * 128 * (D / 8); i += NGT) { const int k0 = (i & 127) * 8, n = (i >> 7) & 127, b = i >> 14; u32x4 w = {0u, 0u, 0u, 0u};
        if (n < 36) { const float* md = X.mod + (size_t)b * NMOD + 4 * D + k0; float v[8];
#pragma unroll
            for (int j = 0; j < 8; ++j) { const int k = k0 + j; const float wr = (n < 4) ? X.rc_w[k * 4 + n] : X.rf_w[k * 32 + (n - 4)]; v[j] = X.g2[k] * (1.0f + md[j]) * wr; }
            w.x = pk2(v[0], v[1]); w.y = pk2(v[2], v[3]); w.z = pk2(v[4], v[5]); w.w = pk2(v[6], v[7]); }
        *(u32x4*)(X.WrB + ((size_t)(b * 128 + n) * D + k0)) = w; }
    for (int it = gw; it < NB * 36; it += NGW) { const int b = it / 36, n = it % 36; const float* sh = X.mod + (size_t)b * NMOD + 3 * D; float sm = 0.f;
#pragma unroll
        for (int j = 0; j < 16; ++j) { const int k = lane_now() + 64 * j; sm += sh[k] * ((n < 4) ? X.rc_w[k * 4 + n] : X.rf_w[k * 32 + (n - 4)]); }
        sm = wave_sum(sm);
        if (lane_now() == 0) X.cbias[b * 64 + n] = sm + ((n < 4) ? X.rc_b[n] : X.rf_b[n - 4]); }
}
__device__ __forceinline__ void p1_inproj(const Ctx& X) {
    for (int tile = X.vcu; tile < T / 256; tile += X.G) {
        p1_rows(X, tile);
        WG_SYNC();
        run_gemm<FAST_P1, false>(X, D, D, SchedTileN{(const char*)(X.u + (size_t)tile * 256 * D), (const char*)X.WinT, (size_t)256 * D * 2, 3, D / 64, (size_t)128 * D * 2}, EpiInProj{X.UX, X.upool, X.b_in, tile});
    }
    p1_tables(X);
    p1_router_fold(X);
}

struct NoCol {};
struct EpiSsum { float* S;
    static constexpr int MB = 4; static constexpr bool PAIR = false;
    typedef NoPre Pre; typedef NoCol Col;
    __device__ __forceinline__ Col col(const Unit&, int) const { return Col{}; }
    __device__ __forceinline__ Pre pre(const Unit&, int, int) const { return Pre{}; }
    __device__ __forceinline__ void operator()(const Unit&, int r, int c, f32x4 v0, f32x4 v1, const Pre&, const Col&) const { if (c < 128) { *(f32x4*)(S + r * 128 + c) = v0; *(f32x4*)(S + r * 128 + c + 4) = v1; } } };
struct EpiS5Y { const bf16* UXg; bf16* YZM; const float* dskip; int g, pm;
    static constexpr int MB = 4; static constexpr bool PAIR = false;
    struct Pre { u32x4 uw; }; struct Col { f32x4 d0, d1; };
    __device__ __forceinline__ Col col(const Unit&, int c) const { const int h0 = c & 15; return Col{*(const f32x4*)(dskip + g * GH + h0), *(const f32x4*)(dskip + g * GH + h0 + 4)}; }
    __device__ __forceinline__ Pre pre(const Unit&, int r, int c) const { const int j = c >> 4, h0 = c & 15, ci = 256 * pm + r;
        return Pre{*(const u32x4*)(UXg + (size_t)ci * KX + 128 + j * 16 + h0)}; }
    __device__ __forceinline__ void operator()(const Unit&, int r, int c, f32x4 v0, f32x4 v1, const Pre& p, const Col& k) const {
        const int j = c >> 4, h0 = c & 15, ci = 256 * pm + r;
        f32x4 u0, u1; unpack8(p.uw, u0, u1);
        v0 += k.d0 * u0; v1 += k.d1 * u1;
#pragma unroll
        for (int i = 0; i < 4; ++i) { v0[i] = gelu_tanh(v0[i]); v1[i] = gelu_tanh(v1[i]); }
        *(u32x4*)(YZM + ((size_t)ci * CH + j) * D + g * GH + h0) = pack8(v0, v1);
    } };
__device__ __forceinline__ void p2_s5(const Ctx& X) {
    for (int id = X.vcu; id < NG * (NCOL / 256); id += X.G) { const int g = id / (NCOL / 256), pm = id % (NCOL / 256);
        bf16* UXg = X.UX + (size_t)g * NCOL * KX; const bf16* Arow = UXg + (size_t)(256 * pm) * KX;
        float* S = X.ssum + (size_t)X.vcu * 256 * 128;
        run_gemm<FAST_P2, false>(X, KX, CHGH, SchedTileN{(const char*)(Arow + 128), (const char*)(X.EtT + (size_t)g * 256 * CHGH), 0, 1, CHGH / 64, (size_t)128 * CHGH * 2}, EpiSsum{S});
        WG_SYNC();
        if (X.wave < 256 / NCHB) { const int bb = X.wave, p = lane_now(); const f32x2 L = X.lpow[((size_t)g * 65 + CH) * NP + p]; float sr = 0.f, si = 0.f;
            for (int c0 = 0; c0 < NCHB; c0 += 32) { float ar[32], ai[32];
#pragma unroll
                for (int c = 0; c < 32; ++c) { const int r = bb * NCHB + c0 + c; ar[c] = S[r * 128 + p]; ai[c] = S[r * 128 + 64 + p]; }
#pragma unroll
                for (int c = 0; c < 32; ++c) { const int r = bb * NCHB + c0 + c; bf16* row = UXg + (size_t)(256 * pm + r) * KX; row[p] = (bf16)f2bf(sr); row[64 + p] = (bf16)f2bf(si);
                    const float nr = L.x * sr - L.y * si + ar[c]; si = L.x * si + L.y * sr + ai[c]; sr = nr; } } }
        WG_SYNC();
        run_gemm<FAST_P2, false>(X, KX, KX, SchedTileN{(const char*)Arow, (const char*)(X.TG + (size_t)g * CHGH * KX), 0, 1, KX / 64, (size_t)128 * KX * 2}, EpiS5Y{UXg, X.YZM, X.ssm_d, g, pm});
        WG_SYNC();
    }
}

struct SchedP3y { const char* yzm; const char* wglu; const char* pssm; const char* weff; int q;
    __device__ __forceinline__ bool next(int i, Unit& un) const { const int k = i + (q != 0); if (k >= 3) return false;
        if (k == 0) { un.A = yzm; un.B = wglu; un.nt = 4; un.i0 = 0; } else if (k == 1) { un.A = yzm + 512 * 2; un.B = weff + (size_t)(256 * q) * D * 2; un.nt = 8; un.i0 = 1; } else { un.A = yzm + 256 * 2; un.B = pssm + (size_t)(256 * q) * D * 2; un.nt = 4; un.i0 = 5; }
        un.B1 = un.B + (size_t)128 * D * 2; un.i1 = 0; un.i2 = 0; un.i3 = 0; return true; }
    __device__ __forceinline__ unsigned row_off(const Unit&, int) const { return 0u; } };
__device__ __forceinline__ size_t lin_elem(int r, int c, int bj) { const int ai = r >> 7, wr = (r >> 6) & 1, m = (r >> 4) & 3, fr = r & 15, wc = (c >> 5) & 3, fq = (c >> 3) & 3;
    return (size_t)((((ai * 4 + m) * 2 + bj) * 512 + (wr * 4 + wc) * 64 + fq * 16 + fr) * 8); }
struct EpiP3y { bf16* YZM; bf16* T1; bf16* T2; const float* b_glu; int tile;
    static constexpr int MB = 4; static constexpr bool PAIR = false;
    struct Pre { u32x4 y; }; struct Col { f32x4 b0, b1; };
    __device__ __forceinline__ Col col(const Unit& u, int c) const { Col k; if (u.i0 == 0) { k.b0 = *(const f32x4*)(b_glu + c); k.b1 = *(const f32x4*)(b_glu + c + 4); } else { k.b0 = (f32x4){0.f, 0.f, 0.f, 0.f}; k.b1 = k.b0; } return k; }
    __device__ __forceinline__ Pre pre(const Unit& u, int r, int c) const { Pre p;
        if (u.i0 == 0) p.y = *(const u32x4*)(YZM + (size_t)(tile * 256 + r) * D + c); else p.y = (u32x4){0u, 0u, 0u, 0u};
        return p; }
    __device__ __forceinline__ void operator()(const Unit& u, int r, int c, f32x4 v0, f32x4 v1, const Pre& p, const Col& k) const { const size_t ro = (size_t)(tile * 256 + r) * D;
        if (u.i0 == 0) { f32x4 y0, y1; unpack8(p.y, y0, y1); *(u32x4*)(YZM + ro + 256 + c) = pack8(y0 * sig4(v0 + k.b0), y1 * sig4(v1 + k.b1)); }
        else { const int q = u.i0 - 1; bf16* O = (q < 4) ? T2 : T1; *(u32x4*)(O + (size_t)(q & 3) * 65536 + lin_elem(r, c & 127, c >> 7)) = pack8(v0, v1); } } };
struct SchedP3g { const char* u; const char* win; int q;
    __device__ __forceinline__ bool next(int i, Unit& un) const { if (i >= 2) return false; const int cb = 2 * q + i;
        un.A = u; un.B = win + (size_t)(128 * cb) * D; un.B1 = win + (size_t)(1024 + 128 * cb) * D; un.nt = 8; un.i0 = cb;   un.i1 = 0; un.i2 = 0; un.i3 = 0; return true; }
    __device__ __forceinline__ unsigned row_off(const Unit&, int) const { return 0u; } };
struct EpiP3g { bf16* P; const bf16* T1; const bf16* T2; const float* b_in; int tile;
    static constexpr int MB = 4; static constexpr bool PAIR = true;
    struct Pre { u32x4 t1, t2; }; struct Col { f32x4 a0, a1, b0, b1; };
    __device__ __forceinline__ Col col(const Unit& u, int c) const { const int cc = 128 * u.i0 + c; return Col{*(const f32x4*)(b_in + 768 + cc), *(const f32x4*)(b_in + 768 + cc + 4), *(const f32x4*)(b_in + 1792 + cc), *(const f32x4*)(b_in + 1792 + cc + 4)}; }
    __device__ __forceinline__ Pre pre(const Unit& u, int r, int c) const { const size_t o = lin_elem(r, c, u.i0 & 1); return Pre{*(const u32x4*)(T1 + o), *(const u32x4*)(T2 + o)}; }
    __device__ __forceinline__ void pair(const Unit& u, int r, int c, f32x4 g0, f32x4 g1, f32x4 h0, f32x4 h1, const Pre& p, const Col& k) const { const size_t o = (size_t)(tile * 256 + r) * D + 128 * u.i0 + c;
        f32x4 x0, x1, y0, y1; unpack8(p.t1, x0, x1); unpack8(p.t2, y0, y1);
        constexpr float inv = 1.0f / (W8_SCALE * A8_SCALE);
        *(u32x4*)(P + o) = pack8(sig4(g0 * inv + k.a0) * x0 + sig4(h0 * inv + k.b0) * y0, sig4(g1 * inv + k.a1) * x1 + sig4(h1 * inv + k.b1) * y1); } };
struct EpiWout { const float* x; const float* gate; bf16* h1; int tile;
    static constexpr int MB = 4; static constexpr bool PAIR = false;
    struct Pre { f32x4 x0, x1; }; struct Col { f32x4 g0, g1; };
    __device__ __forceinline__ Col col(const Unit& u, int c) const { const int cc = 256 * u.i0 + c; return Col{*(const f32x4*)(gate + cc), *(const f32x4*)(gate + cc + 4)}; }
    __device__ __forceinline__ Pre pre(const Unit& u, int r, int c) const { const size_t o = (size_t)(tile * 256 + r) * D + 256 * u.i0 + c; return Pre{*(const f32x4*)(x + o), *(const f32x4*)(x + o + 4)}; }
    __device__ __forceinline__ void operator()(const Unit& u, int r, int c, f32x4 v0, f32x4 v1, const Pre& p, const Col& k) const { const size_t o = (size_t)(tile * 256 + r) * D + 256 * u.i0 + c;
        const f32x4 h0 = p.x0 + k.g0 * v0, h1v = p.x1 + k.g1 * v1;
        *(u32x4*)(h1 + o) = pack8(h0, h1v); } };
struct EpiRouter { float* logits; const float* cb; const LAS float* rstd; int tile;
    static constexpr int MB = 4; static constexpr bool PAIR = false;
    typedef NoPre Pre; typedef NoCol Col;
    __device__ __forceinline__ Col col(const Unit&, int) const { return Col{}; }
    __device__ __forceinline__ Pre pre(const Unit&, int, int) const { return Pre{}; }
    __device__ __forceinline__ void operator()(const Unit&, int r, int c, f32x4 v0, f32x4 v1, const Pre&, const Col&) const { if (c < 40) { float* o = logits + (size_t)(tile * 256 + r) * 64 + c; const float rs = rstd[r];
#pragma unroll
            for (int i = 0; i < 8; ++i) { const int n = c + i; const float bias = (n < 36) ? cb[n] : 0.f; o[i] = (i < 4 ? v0[i & 3] : v1[i & 3]) * rs + bias; } } } };

__device__ __forceinline__ void moe_weights_convert(const Ctx& X) {
    const int gw = X.vcu * NWAVES + X.wave, NGW = X.G * NWAVES;
    LAS float* scr = (LAS float*)(X.lds + X.wave * 16640);
    constexpr int I_G = NE * (D / 64) * (DE / 64), I_D = NE * (DE / 64) * (D / 64);
    for (int it = gw; it < 2 * I_G + I_D; it += NGW) { int r = it;
        if (r < 2 * I_G) { const int up = r >= I_G; if (up) r -= I_G; const int per = (D / 64) * (DE / 64), e = r / per, q = r % per, nb = DE / 64;
            transpose_item_f8((up ? X.moe_u : X.moe_g) + (size_t)e * D * DE, DE, (unsigned char*)X.W1T + (size_t)e * D * D, D, scr, 64 * (q / nb), 64 * (q % nb), lane_now(), NGateUp{up}); continue; } r -= 2 * I_G;
        { const int per = (DE / 64) * (D / 64), e = r / per, q = r % per, nb = D / 64;
            transpose_item_f8(X.moe_d + (size_t)e * DE * D, D, (unsigned char*)X.WdT + (size_t)e * D * DE, DE, scr, 64 * (q / nb), 64 * (q % nb), lane_now(), NId{}); } }
    WG_SYNC();
}
__device__ __forceinline__ void p3_mixer(const Ctx& X, const bool do_route = true) {
    LAS float* rstd_l = (LAS float*)(X.lds + LDS_CTL_OFF + LC_ROWSQ); LAS unsigned* hist = (LAS unsigned*)(X.lds + LDS_CTL_OFF + LC_HIST); LAS unsigned* base = (LAS unsigned*)(X.lds + LDS_CTL_OFF + LC_BASE);
    for (int tile = X.vcu; tile < T / 256; tile += X.G) {
        const int b = tile >> 3, t0 = (tile & 7) * 256; const float* md = X.mod + (size_t)b * NMOD; const size_t tok0 = (size_t)tile * 256;
        if ((X.wave * 64 + lane_now()) < 32) hist[(X.wave * 64 + lane_now())] = 0u;
        { int tq = (X.wave * 64 + lane_now()); asm volatile("" : "+v"(tq)); const int cg = tq & 63, rb = tq >> 6, w = 2 << (cg >> 4), r0 = 32 * rb; const bf16* pb = X.upool + tok0 * DPOOL + 8 * cg; bf16* ob = X.YZM + tok0 * D + 512 + 8 * cg;
            f32x4 S0 = {0.f, 0.f, 0.f, 0.f}, S1 = S0;
            { u32x4 pv[15];
#pragma unroll
                for (int i = 1; i < 16; ++i) pv[i - 1] = *(const u32x4*)(pb + (ptrdiff_t)(r0 - i) * DPOOL);
#pragma unroll
                for (int i = 1; i < 16; ++i) { f32x4 a, bq; unpack8(pv[i - 1], a, bq); const float ok = (i < w && t0 + r0 - i >= 0) ? 1.f : 0.f; S0 += a * ok; S1 += bq * ok; } }
            for (int rr8 = 0; rr8 < 32; rr8 += 8) { u32x4 cu[8], ol[8];
#pragma unroll
                for (int k = 0; k < 8; ++k) { const int r = r0 + rr8 + k; cu[k] = *(const u32x4*)(pb + (ptrdiff_t)r * DPOOL); ol[k] = *(const u32x4*)(pb + (ptrdiff_t)(r - w + 1) * DPOOL); }
#pragma unroll
                for (int k = 0; k < 8; ++k) { const int r = r0 + rr8 + k, t = t0 + r; f32x4 c0, c1, o0, o1; unpack8(cu[k], c0, c1); unpack8(ol[k], o0, o1);
                    S0 += c0; S1 += c1; const float inv = 1.0f / (float)((t + 1 < w) ? t + 1 : w);
                    *(u32x4*)(ob + (size_t)r * D) = pack8(S0 * inv - c0, S1 * inv - c1);
                    const float ok = (t - w + 1 >= 0) ? 1.f : 0.f; S0 -= o0 * ok; S1 -= o1 * ok; } } }
        WG_SYNC();
        const bool conv = do_route && tile == X.vcu; const int cq = X.vcu & 3;
        if (conv && cq == 0) moe_weights_convert(X);
        {
            const SchedTileN sW{(const char*)(X.P + tok0 * D), (const char*)X.WoutT, (size_t)256 * D * 2, 4, D / 64, (size_t)128 * D * 2};
#pragma unroll 1
            for (int q = 0; q < 4; ++q) {
                const SchedP3y sY{(const char*)(X.YZM + tok0 * D), (const char*)X.WgluT, (const char*)X.PssmT, (const char*)X.WeffT, q};
                const SchedP3g sG{(const char*)(X.u8 + tok0 * D), (const char*)X.Wg8, q};
                Unit fG; sG.next(0, fG);
                const bool brk1 = conv && cq == 1 && q == 0, brk2 = conv && cq == 2 && q == 3;
                run_gemm<FAST_P3, false>(X, D, D, sY, EpiP3y{X.YZM, X.h1 + tok0 * D, X.Q + tok0 * D, X.b_glu, tile}, q > 0, !brk1, &fG, D / 2, D / 2);
                WG_SYNC();
                if (brk1) moe_weights_convert(X);
                Unit fN; if (q < 3) { const SchedP3y sY1{sY.yzm, sY.wglu, sY.pssm, sY.weff, q + 1}; sY1.next(0, fN); } else sW.next(0, fN);
                run_gemm<FAST_P3, false, EpiP3g, SchedP3g, true>(X, D / 2, D / 2, sG, EpiP3g{X.P, X.h1 + tok0 * D, X.Q + tok0 * D, X.b_in, tile}, !brk1, !brk2, &fN, D, D);
                WG_SYNC();
                if (brk2) moe_weights_convert(X);
            }
            run_gemm<FAST_P3, false>(X, D, D, sW, EpiWout{X.x, md + 2 * D, X.h1, tile}, !(conv && cq == 2));
            WG_SYNC();
        }
        if (conv && cq == 3) moe_weights_convert(X);
        { int ln = lane_now(); asm volatile("" : "+v"(ln)); f32x4 sc[4], sh[4];
#pragma unroll
            for (int j = 0; j < 2; ++j)
#pragma unroll
                for (int hlf = 0; hlf < 2; ++hlf) { const int c0 = 8 * ln + 512 * j + 4 * hlf; sc[2 * j + hlf] = *(const f32x4*)(X.g2 + c0) * (*(const f32x4*)(md + 4 * D + c0) + 1.0f); sh[2 * j + hlf] = *(const f32x4*)(md + 3 * D + c0); }
            for (int r4 = X.wave; r4 < 256; r4 += 4 * NWAVES) { u32x4 hv[4][2];
#pragma unroll
                for (int k = 0; k < 4; ++k)
#pragma unroll
                    for (int j = 0; j < 2; ++j) hv[k][j] = *(const u32x4*)(X.h1 + (tok0 + r4 + 8 * k) * D + 8 * ln + 512 * j);
#pragma unroll
                for (int k = 0; k < 4; ++k) { const int r = r4 + 8 * k; float ss = 0.f;
#pragma unroll
                    for (int j = 0; j < 2; ++j) { f32x4 a, bq; unpack8(hv[k][j], a, bq); ss += (a.x * a.x + a.y * a.y) + (a.z * a.z + a.w * a.w) + (bq.x * bq.x + bq.y * bq.y) + (bq.z * bq.z + bq.w * bq.w); }
                    const float rstd = 1.0f / sqrtf(wave_sum(ss) * (1.0f / D) + EPS); if (ln == 0) rstd_l[r] = rstd;
#pragma unroll
                    for (int j = 0; j < 2; ++j) { f32x4 a, bq; unpack8(hv[k][j], a, bq); const f32x4 ya = a * rstd * sc[2 * j] + sh[2 * j], yb = bq * rstd * sc[2 * j + 1] + sh[2 * j + 1];
                        u32x2 w8; w8.x = pk4f8(ya * A8_SCALE); w8.y = pk4f8(yb * A8_SCALE); *(u32x2*)(X.u2f8 + (tok0 + r) * D + 8 * ln + 512 * j) = w8; } } } }
        WG_SYNC();
        run_gemm<FAST_P3, false>(X, D, D, SchedTileN{(const char*)(X.h1 + tok0 * D), (const char*)(X.WrB + (size_t)b * 128 * D), 0, 1, D / 64, 0}, EpiRouter{X.logits, X.cbias + b * 64, rstd_l, tile});
        WG_SYNC();
        if (!do_route) continue;
        int tr = (X.wave * 64 + lane_now()); asm volatile("" : "+v"(tr));
        int e0 = 0, e1 = 0; float w0 = 0.f, w1 = 0.f; unsigned rk0 = 0, rk1 = 0;
        if (tr < 256) { const float* lg = X.logits + (tok0 + tr) * 64;
            int grp = 0; float lm = lg[0];
#pragma unroll
            for (int j = 1; j < 4; ++j) { const float v = lg[j]; if (v > lm) { lm = v; grp = j; } }
            float se = 0.f;
#pragma unroll
            for (int j = 0; j < 4; ++j) se += __expf(lg[j] - lm);
            const float pg = 1.0f / se; const float* lf = lg + 4 + grp * 8;
            int i1 = 0; float l1 = lf[0];
#pragma unroll
            for (int j = 1; j < 8; ++j) { const float v = lf[j]; if (v > l1) { l1 = v; i1 = j; } }
            int i2 = -1; float l2 = -3.0e38f;
#pragma unroll
            for (int j = 0; j < 8; ++j) { const float v = lf[j]; if (j != i1 && v > l2) { l2 = v; i2 = j; } }
            const float ex = __expf(l2 - l1); w0 = pg / (1.0f + ex); w1 = pg * ex / (1.0f + ex); e0 = grp * 8 + i1; e1 = grp * 8 + i2;
            rk0 = atomicAdd((unsigned*)(hist + e0), 1u); rk1 = atomicAdd((unsigned*)(hist + e1), 1u); }
        __syncthreads();
        if (tr < 32) base[tr] = atomicAdd(X.ctl + CW_GCNT + tr, (unsigned)hist[tr]);
        __syncthreads();
        if (tr < 256) { const int tok = (int)tok0 + tr; const unsigned p0 = base[e0] + rk0, p1 = base[e1] + rk1;
            X.sorted[(size_t)e0 * CAP + p0] = tok; X.sorted[(size_t)e1 * CAP + p1] = tok;
            *(i32x4*)(X.tokslot + 4 * tok) = (i32x4){(e0 << 16) | (int)p0, (e1 << 16) | (int)p1, __builtin_bit_cast(int, w0), __builtin_bit_cast(int, w1)}; }
        __syncthreads();
    }
}

__device__ __forceinline__ void moe_table(const Ctx& X) {
    LAS unsigned* tp = (LAS unsigned*)(X.lds + LDS_CTL_OFF + LC_TPFX); LAS unsigned* cnt = (LAS unsigned*)(X.lds + LDS_CTL_OFF + LC_CNT); LAS unsigned* ul = (LAS unsigned*)(X.lds + LDS_CTL_OFF + LC_ULIST);
    const int tid = X.wave * 64 + lane_now();
    __syncthreads();
    if (tid < 32) cnt[tid] = __hip_atomic_load(X.ctl + CW_GCNT + tid, __ATOMIC_RELAXED, __HIP_MEMORY_SCOPE_AGENT);
    __syncthreads();
    if (tid == 0) { unsigned s = 0; for (int e = 0; e < NE; ++e) { tp[e] = s; s += (cnt[e] + 255u) >> 8; } tp[NE] = s; }
    __syncthreads();
    if (tid < 63) { const unsigned NU = tp[NE] * 4u, uu = (unsigned)X.vcu + (unsigned)tid * (unsigned)X.G;
        if (uu < NU) { const unsigned mt = uu >> 2, pn = uu & 3; int e = 0; for (int k = 1; k < NE; ++k) if (tp[k] <= mt) e = k; ul[1 + tid] = mt | (pn << 10) | ((unsigned)e << 12) | ((mt - tp[e]) << 17); }
        if (tid == 0) { const unsigned n = (NU > (unsigned)X.vcu) ? (NU - (unsigned)X.vcu + (unsigned)X.G - 1u) / (unsigned)X.G : 0u; ul[0] = n < 63u ? n : 63u; } }
    __syncthreads();
}
__device__ __forceinline__ int find_expert(const LAS unsigned* tp, unsigned mt) { int e = 0;
#pragma unroll 1
    for (int k = 1; k < NE; ++k) if (tp[k] <= mt) e = k;
    return e; }
struct SchedMoe { const LAS unsigned* ul; const LAS unsigned* cnt; const int* sorted; const char* Abase; size_t a_tile; const char* Bbase; size_t b_exp, b_pn, b_half; int nt;
    __device__ __forceinline__ bool next(int i, Unit& u) const { if (i >= (int)__builtin_amdgcn_readfirstlane((int)ul[0])) return false;
        const unsigned w = (unsigned)__builtin_amdgcn_readfirstlane((int)ul[1 + i]); const unsigned mt = w & 1023u; const int pn = (w >> 10) & 3, eu = (w >> 12) & 31, lt = (int)(w >> 17);
        u.A = Abase + (size_t)mt * a_tile; u.B = Bbase + (size_t)eu * b_exp + (size_t)pn * b_pn; u.B1 = u.B + b_half; u.nt = nt; u.i0 = (int)mt; u.i1 = pn; u.i2 = eu; u.i3 = lt; return true; }
    __device__ __forceinline__ unsigned row_off(const Unit& u, int row) const { const int pos = 256 * u.i3 + row; const int tok = (pos < (int)cnt[u.i2]) ? sorted[(size_t)u.i2 * CAP + pos] : 0; return (unsigned)tok * (unsigned)D; } };
struct EpiAct { unsigned char* act;
    static constexpr int MB = 4; static constexpr bool PAIR = true;
    typedef NoPre Pre; typedef NoCol Col;
    __device__ __forceinline__ Col col(const Unit&, int) const { return Col{}; }
    __device__ __forceinline__ Pre pre(const Unit&, int, int) const { return Pre{}; }
    __device__ __forceinline__ void pair(const Unit& u, int r, int c, f32x4 g0, f32x4 g1, f32x4 u0, f32x4 u1, const Pre&, const Col&) const {
        constexpr float inv = 1.0f / (W8_SCALE * A8_SCALE);
#pragma unroll
        for (int i = 0; i < 4; ++i) { const float a = g0[i] * inv, b = g1[i] * inv; g0[i] = a * sigmoidf_(a) * (u0[i] * inv) * A8_SCALE; g1[i] = b * sigmoidf_(b) * (u1[i] * inv) * A8_SCALE; }
        u32x2 w; w.x = pk4f8(g0); w.y = pk4f8(g1); *(u32x2*)(act + ((size_t)u.i0 * 256 + r) * DE + 128 * u.i1 + c) = w; } };
struct EpiDown { unsigned char* ys;
    static constexpr int MB = 4; static constexpr bool PAIR = false;
    typedef NoPre Pre; typedef NoCol Col;
    __device__ __forceinline__ Col col(const Unit&, int) const { return Col{}; }
    __device__ __forceinline__ Pre pre(const Unit&, int, int) const { return Pre{}; }
    __device__ __forceinline__ void operator()(const Unit& u, int r, int c, f32x4 v0, f32x4 v1, const Pre&, const Col&) const { constexpr float sc = Y8_SCALE / (W8_SCALE * A8_SCALE);
        u32x2 w; w.x = pk4f8(v0 * sc); w.y = pk4f8(v1 * sc); *(u32x2*)(ys + ((size_t)u.i0 * 256 + r) * D + 256 * u.i1 + c) = w; } };
__device__ __forceinline__ void p4_moe_up(const Ctx& X) {
    moe_table(X); const LAS unsigned* ul = (const LAS unsigned*)(X.lds + LDS_CTL_OFF + LC_ULIST); const LAS unsigned* cnt = (const LAS unsigned*)(X.lds + LDS_CTL_OFF + LC_CNT);
    run_gemm<FAST_P4, true, EpiAct, SchedMoe, true>(X, D / 2, D / 2, SchedMoe{ul, cnt, X.sorted, (const char*)X.u2f8, 0, (const char*)X.W1T, (size_t)D * D, (size_t)128 * D, (size_t)DE * D, D / 128}, EpiAct{(unsigned char*)X.act});
}
__device__ __forceinline__ void p5_moe_down(const Ctx& X) {
    moe_table(X); const LAS unsigned* ul = (const LAS unsigned*)(X.lds + LDS_CTL_OFF + LC_ULIST); const LAS unsigned* cnt = (const LAS unsigned*)(X.lds + LDS_CTL_OFF + LC_CNT);
    run_gemm<FAST_P5, false, EpiDown, SchedMoe, true>(X, DE / 2, DE / 2, SchedMoe{ul, cnt, X.sorted, (const char*)X.act, (size_t)256 * DE, (const char*)X.WdT, (size_t)D * DE, (size_t)256 * DE, (size_t)128 * DE, DE / 128}, EpiDown{(unsigned char*)X.ys});
}
__device__ __forceinline__ void p6_final(const Ctx& X) {
    moe_table(X); LAS unsigned* tp = (LAS unsigned*)(X.lds + LDS_CTL_OFF + LC_TPFX);
    const int gw = X.vcu * NWAVES + X.wave, NGW = X.G * NWAVES;
    int tsx = 0, tsy = 0, tsz = 0, tsw = 0;
    { const int tokl = gw + lane_now() * NGW; if (tokl < T) { const int* tq = X.tokslot + 4 * tokl; tsx = tq[0]; tsy = tq[1]; tsz = tq[2]; tsw = tq[3]; } }
    int jt = 0;
    for (int tk4 = gw; tk4 < T; tk4 += 4 * NGW, jt += 4) {
        int s0[4], s1[4]; float w0[4], w1[4];
#pragma unroll
        for (int k = 0; k < 4; ++k) { s0[k] = __builtin_amdgcn_readlane(tsx, jt + k); s1[k] = __builtin_amdgcn_readlane(tsy, jt + k);
            w0[k] = __builtin_bit_cast(float, __builtin_amdgcn_readlane(tsz, jt + k)) * (1.0f / Y8_SCALE); w1[k] = __builtin_bit_cast(float, __builtin_amdgcn_readlane(tsw, jt + k)) * (1.0f / Y8_SCALE); }
        u32x4 hv[4][2]; u32x2 av[4][2], bv[4][2]; const unsigned char* ys8 = (const unsigned char*)X.ys;
#pragma unroll
        for (int k = 0; k < 4; ++k) { const int tok = tk4 + k * NGW; const size_t r0 = (size_t)tp[s0[k] >> 16] * 256 + (s0[k] & 0xffff), r1 = (size_t)tp[s1[k] >> 16] * 256 + (s1[k] & 0xffff);
#pragma unroll
            for (int j = 0; j < 2; ++j) { const int c0 = 8 * lane_now() + 512 * j; hv[k][j] = *(const u32x4*)(X.h1 + (size_t)tok * D + c0); av[k][j] = *(const u32x2*)(ys8 + r0 * D + c0); bv[k][j] = *(const u32x2*)(ys8 + r1 * D + c0); } }
#pragma unroll
        for (int k = 0; k < 4; ++k) { const int tok = tk4 + k * NGW, b = tok >> 11; const float* g2 = X.mod + (size_t)b * NMOD + 5 * D;
            f32x4 v[4]; float s = 0.f;
#pragma unroll
            for (int j = 0; j < 2; ++j) { const int c0 = 8 * lane_now() + 512 * j; f32x4 h0, h1v, a0, a1, b0, b1;
                unpack8(hv[k][j], h0, h1v); unpack8f8(av[k][j], a0, a1); unpack8f8(bv[k][j], b0, b1);
                v[2 * j] = h0 + *(const f32x4*)(g2 + c0) * (a0 * w0[k] + b0 * w1[k]); v[2 * j + 1] = h1v + *(const f32x4*)(g2 + c0 + 4) * (a1 * w0[k] + b1 * w1[k]);
#pragma unroll
                for (int q = 0; q < 2; ++q) { const f32x4 t = v[2 * j + q]; s += (t.x * t.x + t.y * t.y) + (t.z * t.z + t.w * t.w); } }
            const float rstd = 1.0f / sqrtf(wave_sum(s) * (1.0f / D) + EPS);
#pragma unroll
            for (int j = 0; j < 2; ++j)
#pragma unroll
                for (int q = 0; q < 2; ++q) { const int c0 = 8 * lane_now() + 512 * j + 4 * q; *(f32x4*)(X.out + (size_t)tok * D + c0) = v[2 * j + q] * rstd * *(const f32x4*)(X.gf + c0); } }
    }
}

struct Args { const float* in[31]; float* out; unsigned char* ws; int ph_lo, ph_hi; };
typedef const Args __attribute__((address_space(4)))* KArgs;
__device__ __forceinline__ Ctx make_ctx(LAS unsigned char* lds, int wave, int vcu, int G) {
    KArgs a = (KArgs)__builtin_amdgcn_kernarg_segment_ptr(); asm volatile("" : "+s"(a));
    Ctx X; X.lds = lds; X.wave = wave; X.vcu = vcu; X.G = G;
    X.x = a->in[0]; X.c = a->in[1]; X.w_mod = a->in[2]; X.b_mod = a->in[3]; X.g1 = a->in[4]; X.w_in = a->in[5]; X.b_in = a->in[6]; X.lam_re = a->in[7]; X.lam_im = a->in[8]; X.log_dt = a->in[9];
    X.b_re = a->in[10]; X.b_im = a->in[11]; X.c_re = a->in[12]; X.c_im = a->in[13]; X.ssm_d = a->in[14]; X.w_glu = a->in[15]; X.b_glu = a->in[16]; X.pool_w = a->in[17]; X.pool_scale = a->in[18];
    X.p_ssm = a->in[19]; X.p_pool = a->in[20]; X.w_out = a->in[21]; X.g2 = a->in[22]; X.rc_w = a->in[23]; X.rc_b = a->in[24]; X.rf_w = a->in[25]; X.rf_b = a->in[26];
    X.moe_g = a->in[27]; X.moe_u = a->in[28]; X.moe_d = a->in[29]; X.gf = a->in[30];
    float* out = a->out; unsigned char* ws = a->ws; X.out = out; X.ws = ws;
    X.ctl = (unsigned*)(ws + WS_CTL); X.mod = (float*)(ws + WS_MOD); X.lpow = (f32x2*)(ws + WS_LPOW); X.bbar = (f32x2*)(ws + WS_BBAR); X.ktab = (float*)(ws + WS_KTAB);
    X.tokslot = (int*)(ws + WS_TOKSLOT); X.sorted = (int*)(ws + WS_SORTED); X.slotw = (float*)(ws + WS_SLOTW); X.logits = (float*)(ws + WS_LOGITS);
    X.WinT = (bf16*)(ws + WS_WIN); X.WgluT = (bf16*)(ws + WS_WGLU); X.PssmT = (bf16*)(ws + WS_PSSM); X.WeffT = (bf16*)(ws + WS_WEFF); X.WoutT = (bf16*)(ws + WS_WOUT); X.WrB = (bf16*)(ws + WS_SLOTW); X.cbias = (float*)(ws + WS_KTAB + 512 * 1024);
    X.W1T = (bf16*)(ws + WS_W1); X.WdT = (bf16*)(ws + WS_WD); X.TG = (bf16*)(ws + WS_TG); X.EtT = (bf16*)(ws + WS_ET); X.ssum = (float*)(ws + WS_SSUM);
    X.h1 = (bf16*)(ws + WS_H1); X.u2 = (bf16*)(ws + WS_U2); X.u = (bf16*)(ws + WS_U); X.UX = (bf16*)(ws + WS_UX); X.upool = (bf16*)(ws + WS_UPOOL); X.YZM = (bf16*)(ws + WS_YZM); X.u2f8 = ws + WS_U2F8; X.u8 = ws + WS_U8; X.Wg8 = ws + WS_WG8;
    X.P = (bf16*)out; X.Q = (bf16*)out + (size_t)T * D; X.act = (bf16*)out; X.ys = (bf16*)(ws + WS_YS);
    return X;
}
__global__ void __launch_bounds__(NTHR, 2) mk_fwd(Args a) {
    extern __shared__ __attribute__((aligned(16))) unsigned char lds_raw[];
    LAS unsigned char* lds = (LAS unsigned char*)lds_raw; const int wave = __builtin_amdgcn_readfirstlane((int)threadIdx.x >> 6);
    const int G = gridDim.x; int vcu; { const int bx = blockIdx.x; vcu = (G % 8 == 0) ? (bx % 8) * (G / 8) + bx / 8 : bx; }
    const int lo = a.ph_lo, hi = a.ph_hi;
#define IN(k) (lo <= (k) && (k) < hi)
#define BOTH(k) (IN(k) && IN((k) + 1))
    for (int i = (wave * 64 + lane_now()); i < (LDS_BYTES - LDS_CTL_OFF) / 4; i += NTHR) ((LAS unsigned*)(lds + LDS_CTL_OFF))[i] = 0u;
    __syncthreads();
    unsigned* barw = (unsigned*)(a.ws + WS_CTL) + CW_BAR;
    XcdBarrier bar; bar.bar = barw; bar.x = 0; bar.st = nullptr; bar.wave = wave;
    if (hi - lo > 1) bar = xcd_barrier_post(barw, (volatile LAS unsigned*)(lds + LDS_CTL_OFF + LC_MISC), wave);
    if (IN(0)) { { const Ctx X = make_ctx(lds, wave, vcu, G); p0_prep(X); } if (BOTH(0)) xcd_barrier(bar); }
    if (IN(1)) { { const Ctx X = make_ctx(lds, wave, vcu, G); p1_inproj(X); } if (BOTH(1)) xcd_barrier(bar); }
    if (IN(2)) { { const Ctx X = make_ctx(lds, wave, vcu, G); p2_s5(X); } if (BOTH(2)) xcd_barrier(bar); }
    if (IN(3)) { { const Ctx X = make_ctx(lds, wave, vcu, G); p3_mixer(X, true); } if (BOTH(3)) xcd_barrier(bar); }
    if (IN(4)) { { const Ctx X = make_ctx(lds, wave, vcu, G); p4_moe_up(X); } if (BOTH(4)) xcd_barrier(bar); }
    if (IN(5)) { { const Ctx X = make_ctx(lds, wave, vcu, G); p5_moe_down(X); } if (BOTH(5)) xcd_barrier(bar); }
    if (IN(6)) { const Ctx X = make_ctx(lds, wave, vcu, G); p6_final(X); }
#undef BOTH
#undef IN
}

extern "C" void kernel_launch(void* const* d_in, const int* in_sizes, int n_in, void* d_out, int out_size, void* d_ws, size_t ws_size, hipStream_t stream) {
    static int grid = 0;
    if (grid == 0) {
        if (n_in != 31 || out_size != T * D || ws_size < WS_END) { fprintf(stderr, "kernel_launch: unexpected shapes (n_in %d out %d ws %zu)\n", n_in, out_size, ws_size); grid = -1; return; }
        int dev = 0, cus = 0;
        if (hipGetDevice(&dev) != hipSuccess || hipDeviceGetAttribute(&cus, hipDeviceAttributeMultiprocessorCount, dev) != hipSuccess) { grid = -1; return; }
        if (hipFuncSetAttribute((const void*)mk_fwd, hipFuncAttributeMaxDynamicSharedMemorySize, LDS_BYTES) != hipSuccess) { fprintf(stderr, "kernel_launch: hipFuncSetAttribute failed\n"); grid = -1; return; }
        grid = cus;
    }
    if (grid < 0) return;
    (void)hipMemsetAsync((char*)d_ws + WS_CTL, 0, CTL_ZERO_BYTES, stream);
    Args a{};
    for (int i = 0; i < 31; ++i) a.in[i] = (const float*)d_in[i];
    a.out = (float*)d_out; a.ws = (unsigned char*)d_ws;
    for (int li = 0; li < MK_N_LAUNCHES; ++li) {
        a.ph_lo = (MK_N_LAUNCHES == 7) ? li : 0; a.ph_hi = (MK_N_LAUNCHES == 7) ? li + 1 : 7;
        hipLaunchKernelGGL(mk_fwd, dim3(grid), dim3(NTHR), LDS_BYTES, stream, a);
    }
}
```
